# Optimizing an MI355X kernel written in HIP

```python
import math
import jax
import jax.numpy as jnp
from jax import lax
import numpy as np

D_MODEL = 1024
BATCH = 4
SEQ = 4096
DEPTH = 2
DEC_BATCH = 128
DEC_SEQ = 1
PAST_LEN = 8192
PAGE_SIZE = 128

GDN_HEADS = 8
GDN_DK = 128
GDN_DV = 128
GDN_QK_W = GDN_HEADS * GDN_DK
GDN_V_W = GDN_HEADS * GDN_DV
CONV_W = 4
CONV_CH = 2 * GDN_QK_W + GDN_V_W
CHUNK = 64
N_Q_HEADS = 16
N_KV_HEADS = 4
HEAD_DIM = 64
Q_GROUP = N_Q_HEADS // N_KV_HEADS
ATT_W = N_Q_HEADS * HEAD_DIM
KV_W = N_KV_HEADS * HEAD_DIM
WINDOW = 128
BLOCK = 128
EPS = 1e-6

kernel_name = 'yoco_gdn_swa_sink_step'


def rmsnorm(x, g):
    xf = x.astype(jnp.float32)
    y = xf * lax.rsqrt(jnp.mean(xf * xf, axis=-1, keepdims=True) + EPS)
    return (y * g.astype(jnp.float32)).astype(x.dtype)


def l2norm(x):
    xf = x.astype(jnp.float32)
    return xf * lax.rsqrt(jnp.sum(xf * xf, axis=-1, keepdims=True) + EPS)


def alibi_slopes(n):
    return jnp.exp2(-8.0 * jnp.arange(1, n + 1, dtype=jnp.float32) / n)


def causal_conv_silu(u, buf, w):
    L = u.shape[1]
    full = jnp.concatenate([buf.astype(u.dtype), u], axis=1)
    out = sum(full[:, i:i + L] * w[i] for i in range(CONV_W))
    return jax.nn.silu(out), full[:, L:]


def _to_chunks(a, n, c):
    a = a.reshape((a.shape[0], n, c) + a.shape[2:])
    return jnp.moveaxis(a, 3, 2)


def gated_delta_rule(q, k, v, g, beta, s0):
    b, L, h, dk = q.shape
    dv = v.shape[-1]
    c = min(CHUNK, L)
    pad = (-L) % c
    if pad:
        q, k, v, g, beta = [jnp.pad(a, [(0, 0), (0, pad)] + [(0, 0)] * (a.ndim - 2)) for a in (q, k, v, g, beta)]
    n = (L + pad) // c
    qc, kc, vc, gc, bc = [_to_chunks(a, n, c) for a in (q, k, v, g, beta)]
    G = jnp.cumsum(gc, axis=-1)
    idx = jnp.arange(c)
    causal = idx[:, None] >= idx[None, :]
    strict = idx[:, None] > idx[None, :]
    decay = jnp.exp(jnp.where(causal, G[..., :, None] - G[..., None, :], -jnp.inf))
    kb = kc * bc[..., None]
    m = jnp.where(strict, jnp.einsum('bnhid,bnhjd->bnhij', kb, kc) * decay, 0.0)
    eye = jnp.eye(c, dtype=jnp.float32)
    rhs = jnp.concatenate([vc * bc[..., None], kb * jnp.exp(G)[..., None]], axis=-1)
    sol = lax.linalg.triangular_solve(eye + m, rhs, left_side=True, lower=True, unit_diagonal=True)
    u_val, w_k = sol[..., :dv], sol[..., dv:]
    qk = jnp.where(causal, jnp.einsum('bnhid,bnhjd->bnhij', qc, kc) * decay, 0.0)
    q_dec = qc * jnp.exp(G)[..., None]
    k_dec = kc * jnp.exp(G[..., -1:] - G)[..., None]
    g_tot = jnp.exp(G[..., -1])

    def step(s, xs):
        u_i, w_i, qk_i, qd_i, kd_i, gt_i = xs
        v_new = u_i - jnp.einsum('bhcd,bhde->bhce', w_i, s)
        o_i = jnp.einsum('bhcd,bhde->bhce', qd_i, s) + jnp.einsum('bhij,bhje->bhie', qk_i, v_new)
        s = s * gt_i[..., None, None] + jnp.einsum('bhcd,bhce->bhde', kd_i, v_new)
        return s, o_i

    xs = tuple(jnp.moveaxis(a, 1, 0) for a in (u_val, w_k, qk, q_dec, k_dec, g_tot))
    s_fin, o = lax.scan(step, s0, xs)
    o = jnp.moveaxis(o, (0, 2), (1, 3)).reshape(b, n * c, h, dv)[:, :L]
    return o, s_fin


def gdn_layer(x, conv_buf, s0, norm_g, w_in, conv_w, a_log, dt_bias, o_norm, w_out):
    b, L, _ = x.shape
    proj = rmsnorm(x, norm_g) @ w_in
    qkv, gate, a, beta_logit = jnp.split(proj, [CONV_CH, CONV_CH + GDN_V_W, CONV_CH + GDN_V_W + GDN_HEADS], axis=-1)
    qkv, new_buf = causal_conv_silu(qkv, conv_buf, conv_w)
    q, k, v = jnp.split(qkv, [GDN_QK_W, 2 * GDN_QK_W], axis=-1)
    q = l2norm(q.reshape(b, L, GDN_HEADS, GDN_DK)) * (GDN_DK ** -0.5)
    k = l2norm(k.reshape(b, L, GDN_HEADS, GDN_DK))
    v = v.reshape(b, L, GDN_HEADS, GDN_DV).astype(jnp.float32)
    beta = jax.nn.sigmoid(beta_logit.astype(jnp.float32))
    g = -jnp.exp(a_log.astype(jnp.float32)) * jax.nn.softplus(a.astype(jnp.float32) + dt_bias.astype(jnp.float32))
    o, s_fin = gated_delta_rule(q, k, v, g, beta, s0.astype(jnp.float32))
    o = rmsnorm(o, o_norm) * jax.nn.silu(gate.reshape(b, L, GDN_HEADS, GDN_DV).astype(jnp.float32))
    y = o.reshape(b, L, GDN_V_W).astype(x.dtype) @ w_out
    return x + y, new_buf, s_fin.astype(s0.dtype)


def shared_kv(h, kv_norm, w_kv, k_norm):
    b, L, _ = h.shape
    k, v = jnp.split(rmsnorm(h, kv_norm) @ w_kv, 2, axis=-1)
    k = rmsnorm(k.reshape(b, L, N_KV_HEADS, HEAD_DIM), k_norm)
    return k, v.reshape(b, L, N_KV_HEADS, HEAD_DIM)


def band_blocks(t, nb):
    tb = t.reshape((t.shape[0], nb, BLOCK) + t.shape[2:])
    prev = jnp.concatenate([jnp.zeros_like(tb[:, :1]), tb[:, :-1]], axis=1)
    return jnp.concatenate([prev, tb], axis=2)


def windowed_sink_attention(q, k, v, dist, valid, sinks):
    slopes = alibi_slopes(N_Q_HEADS).reshape(N_KV_HEADS, Q_GROUP, 1, 1)
    s = jnp.einsum('bnqhgd,bnshd->bnhgqs', q, k, preferred_element_type=jnp.float32) * (HEAD_DIM ** -0.5)
    s = jnp.where(valid[None, :, None, None], s - slopes * dist.astype(jnp.float32), -jnp.inf)
    sink = sinks.astype(jnp.float32).reshape(1, 1, N_KV_HEADS, Q_GROUP, 1, 1)
    mx = jnp.maximum(jnp.max(s, axis=-1, keepdims=True), sink)
    p = jnp.exp(s - mx)
    p = p / (jnp.sum(p, axis=-1, keepdims=True) + jnp.exp(sink - mx))
    return jnp.einsum('bnhgqs,bnshd->bnqhgd', p.astype(v.dtype), v)


def swa_layer(x, kb, vb, dist, valid, norm_g, w_in, q_norm, sinks, w_out):
    b, L, _ = x.shape
    n_blk = kb.shape[1]
    q, gate = jnp.split(rmsnorm(x, norm_g) @ w_in, 2, axis=-1)
    q = rmsnorm(q.reshape(b, L, N_Q_HEADS, HEAD_DIM), q_norm)
    q = q.reshape(b, n_blk, L // n_blk, N_KV_HEADS, Q_GROUP, HEAD_DIM)
    o = windowed_sink_attention(q, kb, vb, dist, valid, sinks).reshape(b, L, ATT_W)
    o = o * jax.nn.silu(gate)
    return x + o @ w_out


def setup_inputs(seed: int = 0) -> dict:
    key = jax.random.key(seed)
    ks = jax.random.split(key, 24)
    n_a = DEPTH // 2
    n_b = DEPTH - n_a
    f32 = jnp.float32

    def nrm(k, shape, scale):
        return jax.random.normal(k, shape, f32) * scale

    def gain(k, shape):
        return 1.0 + 0.05 * jax.random.normal(k, shape, f32)

    in_a = CONV_CH + GDN_V_W + 2 * GDN_HEADS
    dt = jnp.exp(jax.random.uniform(ks[9], (n_a, GDN_HEADS), f32, math.log(1e-3), math.log(1e-1)))
    return {
        'x_prompt': nrm(ks[0], (BATCH, SEQ, D_MODEL), 1.0),
        'x_sample': nrm(ks[1], (DEC_BATCH, DEC_SEQ, D_MODEL), 1.0),
        'state_conv': nrm(ks[2], (n_a, DEC_BATCH, CONV_W - 1, CONV_CH), 1.0),
        'state_ssm': nrm(ks[3], (n_a, DEC_BATCH, GDN_HEADS, GDN_DK, GDN_DV), GDN_DK ** -0.5),
        'cache_k_win': nrm(ks[4], (DEC_BATCH, WINDOW, N_KV_HEADS, HEAD_DIM), 1.0),
        'cache_v_win': nrm(ks[5], (DEC_BATCH, WINDOW, N_KV_HEADS, HEAD_DIM), 1.0),
        'norm_a': gain(ks[6], (n_a, D_MODEL)),
        'w_in_a': nrm(ks[7], (n_a, D_MODEL, in_a), D_MODEL ** -0.5),
        'conv_w_a': nrm(ks[8], (n_a, CONV_W, CONV_CH), CONV_W ** -0.5),
        'a_log': jnp.log(jax.random.uniform(ks[10], (n_a, GDN_HEADS), f32, 1.0, 16.0)),
        'dt_bias': dt + jnp.log(-jnp.expm1(-dt)),
        'o_norm_a': gain(ks[11], (n_a, GDN_DV)),
        'w_out_a': nrm(ks[12], (n_a, GDN_V_W, D_MODEL), GDN_V_W ** -0.5),
        'kv_norm': gain(ks[13], (D_MODEL,)),
        'w_kv': nrm(ks[14], (D_MODEL, 2 * KV_W), D_MODEL ** -0.5),
        'k_norm': gain(ks[15], (HEAD_DIM,)),
        'norm_b': gain(ks[16], (n_b, D_MODEL)),
        'w_in_b': nrm(ks[17], (n_b, D_MODEL, 2 * ATT_W), D_MODEL ** -0.5),
        'q_norm': gain(ks[18], (n_b, HEAD_DIM)),
        'sinks': nrm(ks[19], (n_b, N_Q_HEADS), 0.5),
        'w_out_b': nrm(ks[20], (n_b, ATT_W, D_MODEL), ATT_W ** -0.5),
    }


def reference(x_prompt, x_sample, state_conv, state_ssm, cache_k_win, cache_v_win,
              norm_a, w_in_a, conv_w_a, a_log, dt_bias, o_norm_a, w_out_a,
              kv_norm, w_kv, k_norm, norm_b, w_in_b, q_norm, sinks, w_out_b):
    n_a = DEPTH // 2
    bp, lp, _ = x_prompt.shape
    ls = x_sample.shape[1]
    nb = lp // BLOCK
    qi = jnp.arange(BLOCK)[:, None]
    kj = jnp.arange(2 * BLOCK)[None, :]
    dist_p = qi - kj + BLOCK
    valid_p = (dist_p >= 0) & (dist_p <= WINDOW) & ((jnp.arange(nb)[:, None, None] > 0) | (kj >= BLOCK))
    dist_s = jnp.arange(ls)[:, None] - jnp.arange(-WINDOW, ls)[None, :]
    valid_s = ((dist_s >= 0) & (dist_s <= WINDOW))[None]

    hp, hs = x_prompt, x_sample
    conv_p, ssm_p, conv_s, ssm_s = [], [], [], []
    for layer in range(DEPTH):
        if layer < n_a:
            wa = (norm_a[layer], w_in_a[layer], conv_w_a[layer], a_log[layer], dt_bias[layer],
                  o_norm_a[layer], w_out_a[layer])
            hp, cbuf, st = gdn_layer(hp, jnp.zeros((bp, CONV_W - 1, CONV_CH), hp.dtype),
                                     jnp.zeros((bp,) + state_ssm.shape[2:], state_ssm.dtype), *wa)
            conv_p.append(cbuf)
            ssm_p.append(st)
            hs, cbuf, st = gdn_layer(hs, state_conv[layer], state_ssm[layer], *wa)
            conv_s.append(cbuf)
            ssm_s.append(st)
        else:
            if layer == n_a:
                kp, vp = shared_kv(hp, kv_norm, w_kv, k_norm)
                kn, vn = shared_kv(hs, kv_norm, w_kv, k_norm)
                k_win_p, v_win_p = kp[:, -WINDOW:], vp[:, -WINDOW:]
                k_all_s = jnp.concatenate([cache_k_win.astype(kn.dtype), kn], axis=1)
                v_all_s = jnp.concatenate([cache_v_win.astype(vn.dtype), vn], axis=1)
                k_win_s, v_win_s = k_all_s[:, -WINDOW:], v_all_s[:, -WINDOW:]
                k_band, v_band = band_blocks(kp, nb), band_blocks(vp, nb)
                k_s_blk, v_s_blk = k_all_s[:, None], v_all_s[:, None]
            j = layer - n_a
            wb = (norm_b[j], w_in_b[j], q_norm[j], sinks[j], w_out_b[j])
            hp = swa_layer(hp, k_band, v_band, dist_p, valid_p, *wb)
            hs = swa_layer(hs, k_s_blk, v_s_blk, dist_s, valid_s, *wb)
    conv_prompt, ssm_prompt = jnp.stack(conv_p), jnp.stack(ssm_p)
    conv_sample, ssm_sample = jnp.stack(conv_s), jnp.stack(ssm_s)
    return (hp, hs, conv_prompt, ssm_prompt, k_win_p, v_win_p, conv_sample, ssm_sample, k_win_s, v_win_s)
```

```cpp
#include <hip/hip_runtime.h>
#include <hip/hip_cooperative_groups.h>
#include <cstdio>
#include <cstdint>
namespace cg = cooperative_groups;
#ifndef MK_N_LAUNCHES
#define MK_N_LAUNCHES 1
#define MK_STOP 9
#ifndef MK_DOUBLE
#define MK_DOUBLE -1
#endif
#endif
namespace pg8 {
#define PG8_LAS __attribute__((address_space(3)))
typedef unsigned short bf16_t;
typedef short bf16x8 __attribute__((ext_vector_type(8)));
typedef float f32x4 __attribute__((ext_vector_type(4)));
typedef unsigned u32x4 __attribute__((ext_vector_type(4)));
constexpr int BM = 256, BK = 64, HALF = 128, HTB = HALF * BK * 2  , STAGE_BYTES = 8 * HTB, NXCD = 8, WGM = 8;

__host__ __device__ __forceinline__ int lds_byte(int r, int c) { const int st = (r >> 4) * 2 + (c >> 5), rr = r & 15, cc = c & 31, ob = rr * 64 + cc * 2; return st * 1024 + (ob ^ (((ob >> 9) & 1) << 5)); }
__host__ __device__ __forceinline__ void stage_rc(int b, int& R, int& C) { const int st = b / 1024, sb = b % 1024, swz = sb ^ (((sb >> 9) & 1) << 5); R = (st >> 1) * 16 + swz / 64; C = (st & 1) * 32 + (swz % 64) / 2; }
__host__ __device__ __forceinline__ int perm32(int rho) { const int n = rho >> 4, i = rho & 15; return 8 * (i >> 2) + 4 * n + (i & 3); }

struct Unit { int pm, pn; };
struct Gemm { const bf16_t* A; const bf16_t* Bt; int M, N, K; };

struct StaticOrder {
    int nM, nN, nwg, G, c;
    __host__ __device__ void init(int M, int N, int G_, int c_) { nM = M / BM; nN = N / BM; nwg = nM * nN; G = G_; c = c_; }
    __host__ __device__ bool next(int i, Unit& u) const {
        const long L = (long)i * G + c; if (L >= nwg) return false;
        int wgid = (int)L; { const int q = nwg / NXCD, r = nwg % NXCD, xcd = wgid % NXCD, off = wgid / NXCD; wgid = (xcd < r ? xcd * (q + 1) : r * (q + 1) + (xcd - r) * q) + off; }
        const int nig = WGM * nN, gid = wgid / nig, fm = gid * WGM, gsz = (nM - fm) < WGM ? (nM - fm) : WGM;
        u.pm = fm + ((wgid % nig) % gsz); u.pn = (wgid % nig) / gsz; return true;
    }
    __device__ __forceinline__ void a_ready(const Unit&) const {}
    __device__ __forceinline__ void done(const Unit&) const {}
};

__device__ __forceinline__ unsigned cvt_pk_bf16(float lo, float hi) { unsigned r; asm volatile("v_cvt_pk_bf16_f32 %0, %1, %2" : "=v"(r) : "v"(lo), "v"(hi)); return r; }
template <class Epi, class Sched, bool ALIGN_EPI = false, bool SP2 = false>
__device__ __forceinline__ void gemm_phase(PG8_LAS unsigned char* lds, const Gemm g, const Sched& S, const Epi& E) {
    const int tid = threadIdx.x, wid = __builtin_amdgcn_readfirstlane(tid >> 6), lane = tid & 63, wr = wid >> 2, wc = wid & 3, fr = lane & 15, fq = lane >> 4;
    const int K = g.K, nt = K / BK;
    unsigned voffA[2], voffB[2];
#pragma unroll
    for (int i = 0; i < 2; ++i) { int R, C; stage_rc(tid * 16 + i * 8192, R, C); const int Rb = Epi::PERM ? ((R & ~31) + perm32(R & 31)) : R;
        voffA[i] = (unsigned)(R * K + C) * 2u; voffB[i] = (unsigned)(Rb * K + C) * 2u; }
    const size_t kstep = (size_t)(BK * 2);
    const size_t hstep = (size_t)HALF * K * 2;
    const size_t tstep = 2 * hstep;
    const unsigned ldsw = (unsigned)wid * 1024u;
    const int aoff = lds_byte(wr * 64 + fr, fq * 8), boff = lds_byte(wc * 32 + fr, fq * 8);
#define PG8_SA(b, h) (((b) * 2 + (h)) * HTB)
#define PG8_SB(b, h) ((4 + (b) * 2 + (h)) * HTB)
#define PG8_STAGE(bufoff, gbase, voff) do { _Pragma("unroll") for (int _i = 0; _i < 2; ++_i) \
        __builtin_amdgcn_global_load_lds((const unsigned*)((const char*)(gbase) + (voff)[_i]), (PG8_LAS unsigned*)(lds + (bufoff) + ldsw + _i * 8192), 16, 0, 0); } while (0)
#define PG8_LDA(dst, b, h) do { _Pragma("unroll") for (int m = 0; m < 4; ++m) _Pragma("unroll") for (int k = 0; k < 2; ++k) dst[m][k] = *(const PG8_LAS bf16x8*)(lds + PG8_SA(b, h) + aoff + m * 2048 + k * 1024); } while (0)
#define PG8_LDB(dst, b, h) do { _Pragma("unroll") for (int n = 0; n < 2; ++n) _Pragma("unroll") for (int k = 0; k < 2; ++k) dst[n][k] = *(const PG8_LAS bf16x8*)(lds + PG8_SB(b, h) + boff + n * 2048 + k * 1024); } while (0)
#define PG8_MMA(ai, bj, At, Bt) do { __builtin_amdgcn_s_setprio(1); _Pragma("unroll") for (int m = 0; m < 4; ++m) _Pragma("unroll") for (int n = 0; n < 2; ++n) _Pragma("unroll") for (int k = 0; k < 2; ++k) \
        acc[ai][bj][m][n] = __builtin_amdgcn_mfma_f32_16x16x32_bf16(Bt[n][k], At[m][k], acc[ai][bj][m][n], 0, 0, 0); __builtin_amdgcn_s_setprio(0); } while (0)
#define PG8_WAIT_V(n) asm volatile("s_waitcnt vmcnt(" #n ")" ::: "memory")
#define PG8_WAIT_L(n) asm volatile("s_waitcnt lgkmcnt(" #n ")" ::: "memory")
#define PG8_BAR __builtin_amdgcn_s_barrier()
#define PG8_SCHED __builtin_amdgcn_sched_barrier(0)
    Unit cur, nxt; int ui = 0;
    if (!S.next(0, cur)) return;
    f32x4 acc[2][2][4][2];
#pragma unroll
    for (int a = 0; a < 2; ++a)
#pragma unroll
        for (int b = 0; b < 2; ++b)
#pragma unroll
            for (int m = 0; m < 4; ++m)
#pragma unroll
                for (int n = 0; n < 2; ++n) acc[a][b][m][n] = (f32x4){0.f, 0.f, 0.f, 0.f};
    bf16x8 At[4][2], B0[2][2], B1[2][2];
    const char* cA = (const char*)g.A + (size_t)cur.pm * tstep; const char* cB = (const char*)g.Bt + (size_t)cur.pn * tstep;
    S.a_ready(cur);
    if constexpr (SP2) {
        PG8_STAGE(PG8_SB(0, 0), cB, voffB); PG8_STAGE(PG8_SB(0, 1), cB + hstep, voffB); PG8_STAGE(PG8_SA(0, 0), cA, voffA); PG8_STAGE(PG8_SA(0, 1), cA + hstep, voffA);
        if (wr == 1) PG8_BAR;
        PG8_WAIT_V(2); PG8_BAR;
        PG8_STAGE(PG8_SB(1, 0), cB + kstep, voffB); PG8_STAGE(PG8_SA(1, 0), cA + kstep, voffA); PG8_STAGE(PG8_SB(1, 1), cB + hstep + kstep, voffB);
        PG8_WAIT_V(6); PG8_BAR;
    } else {
        PG8_STAGE(PG8_SB(0, 0), cB, voffB); PG8_STAGE(PG8_SA(0, 0), cA, voffA); PG8_STAGE(PG8_SB(0, 1), cB + hstep, voffB); PG8_STAGE(PG8_SA(0, 1), cA + hstep, voffA);
        if (wr == 1) PG8_BAR;
        PG8_WAIT_V(4); PG8_BAR;
        PG8_STAGE(PG8_SB(1, 0), cB + kstep, voffB); PG8_STAGE(PG8_SA(1, 0), cA + kstep, voffA); PG8_STAGE(PG8_SB(1, 1), cB + hstep + kstep, voffB);
        PG8_WAIT_V(6); PG8_BAR;
    }
    for (;;) {
        const bool has_next = S.next(ui + 1, nxt);
        const char* nA = has_next ? (const char*)g.A + (size_t)nxt.pm * tstep : cA; const char* nB = has_next ? (const char*)g.Bt + (size_t)nxt.pn * tstep : cB;
        for (int t = 0; t < nt; t += 2) {
            const bool last = (t == nt - 2);
            const char* a1 = cA + (size_t)(t + 1) * kstep;
            const char* a2 = last ? nA : cA + (size_t)(t + 2) * kstep; const char* b2 = last ? nB : cB + (size_t)(t + 2) * kstep;
            const char* a3 = a2 + kstep; const char* b3 = b2 + kstep;
            if (last && has_next) S.a_ready(nxt);
            if constexpr (SP2) {
            PG8_LDB(B0, 0, 0); PG8_LDB(B1, 0, 1); PG8_SCHED; PG8_LDA(At, 0, 0); PG8_STAGE(PG8_SA(1, 1), a1 + hstep, voffA);
            PG8_WAIT_V(8); PG8_WAIT_L(0); PG8_BAR; PG8_MMA(0, 0, At, B0); PG8_MMA(0, 1, At, B1); PG8_BAR; PG8_SCHED;
            PG8_LDA(At, 0, 1); PG8_STAGE(PG8_SB(0, 0), b2, voffB); PG8_STAGE(PG8_SB(0, 1), b2 + hstep, voffB); PG8_STAGE(PG8_SA(0, 0), a2, voffA);
            PG8_WAIT_V(8); PG8_WAIT_L(0); PG8_BAR; PG8_MMA(1, 0, At, B0); PG8_MMA(1, 1, At, B1); PG8_BAR; PG8_SCHED;
            PG8_LDB(B0, 1, 0); PG8_LDB(B1, 1, 1); PG8_SCHED; PG8_LDA(At, 1, 0); PG8_STAGE(PG8_SA(0, 1), a2 + hstep, voffA);
            PG8_WAIT_V(8); PG8_WAIT_L(0); PG8_BAR; PG8_MMA(0, 0, At, B0); PG8_MMA(0, 1, At, B1); PG8_BAR; PG8_SCHED;
            PG8_LDA(At, 1, 1); PG8_STAGE(PG8_SB(1, 0), b3, voffB); PG8_STAGE(PG8_SB(1, 1), b3 + hstep, voffB); PG8_STAGE(PG8_SA(1, 0), a3, voffA);
            PG8_WAIT_V(8); PG8_WAIT_L(0); PG8_BAR; PG8_MMA(1, 0, At, B0); PG8_MMA(1, 1, At, B1); PG8_BAR; PG8_SCHED;
            } else {
            PG8_LDB(B0, 0, 0); PG8_SCHED; PG8_LDA(At, 0, 0); PG8_STAGE(PG8_SA(1, 1), a1 + hstep, voffA);
            PG8_WAIT_L(8); PG8_BAR; PG8_WAIT_L(0); PG8_MMA(0, 0, At, B0); PG8_BAR; PG8_SCHED;
            PG8_LDB(B1, 0, 1); PG8_STAGE(PG8_SB(0, 0), b2, voffB);
            PG8_BAR; PG8_WAIT_L(0); PG8_MMA(0, 1, At, B1); PG8_BAR;
            PG8_LDA(At, 0, 1); PG8_STAGE(PG8_SA(0, 0), a2, voffA);
            PG8_BAR; PG8_WAIT_L(0); PG8_MMA(1, 0, At, B0); PG8_BAR; PG8_SCHED;
            PG8_STAGE(PG8_SB(0, 1), b2 + hstep, voffB);
            PG8_WAIT_V(6); PG8_BAR; PG8_MMA(1, 1, At, B1); PG8_BAR;
            PG8_LDB(B0, 1, 0); PG8_SCHED; PG8_LDA(At, 1, 0); PG8_STAGE(PG8_SA(0, 1), a2 + hstep, voffA);
            PG8_WAIT_L(8); PG8_BAR; PG8_WAIT_L(0); PG8_MMA(0, 0, At, B0); PG8_BAR; PG8_SCHED;
            PG8_LDB(B1, 1, 1); PG8_STAGE(PG8_SB(1, 0), b3, voffB);
            PG8_BAR; PG8_WAIT_L(0); PG8_MMA(0, 1, At, B1); PG8_BAR;
            PG8_LDA(At, 1, 1); PG8_STAGE(PG8_SA(1, 0), a3, voffA);
            PG8_BAR; PG8_WAIT_L(0); PG8_MMA(1, 0, At, B0); PG8_BAR; PG8_SCHED;
            PG8_STAGE(PG8_SB(1, 1), b3 + hstep, voffB);
            PG8_WAIT_V(6); PG8_BAR; PG8_MMA(1, 1, At, B1); PG8_BAR;
            }
        }
        if constexpr (ALIGN_EPI) { if (wr == 0) PG8_BAR; }
        if constexpr (!Epi::AFTER_DRAIN) { E(acc, cur, wr, wc, fr, fq); S.done(cur); }
        if (!has_next) break;
#pragma unroll
        for (int a = 0; a < 2; ++a)
#pragma unroll
            for (int b = 0; b < 2; ++b)
#pragma unroll
                for (int m = 0; m < 4; ++m)
#pragma unroll
                    for (int n = 0; n < 2; ++n) acc[a][b][m][n] = (f32x4){0.f, 0.f, 0.f, 0.f};
        cur = nxt; cA = nA; cB = nB; ++ui;
        if constexpr (ALIGN_EPI) { if (wr == 1) PG8_BAR; }
    }
    PG8_WAIT_V(0);
    if constexpr (!ALIGN_EPI) { if (wr == 0) PG8_BAR; }
    PG8_BAR;
    if constexpr (Epi::AFTER_DRAIN) { E.fused(acc, cur, wr, wc, fr, fq, lds, wid, lane); S.done(cur); }
#undef PG8_SA
#undef PG8_SB
#undef PG8_STAGE
#undef PG8_LDA
#undef PG8_LDB
#undef PG8_MMA
#undef PG8_WAIT_V
#undef PG8_WAIT_L
#undef PG8_BAR
#undef PG8_SCHED
}
}

using pg8::bf16_t; using pg8::bf16x8; using pg8::f32x4; using pg8::u32x4;
typedef short s16x4 __attribute__((ext_vector_type(4)));
typedef short v4i16_t __attribute__((ext_vector_type(4)));
typedef unsigned u32x2 __attribute__((ext_vector_type(2)));
#define LAS __attribute__((address_space(3)))
#define DEV __device__ __forceinline__

constexpr int NP = 16384, NS = 128, NR = NP + NS;
constexpr float EPS = 1e-6f;
constexpr size_t O_YP = 0, O_YS = 16777216, O_CONVP = 16908288, O_SSMP = 16945152, O_KWP = 17469440, O_VWP = 17600512,
                 O_CONVS = 17731584, O_SSMS = 18911232, O_KWS = 35688448, O_VWS = 39882752;
constexpr size_t MiB = 1u << 20;
constexpr size_t WS_CTL = 0, CTL_BYTES = 1 * MiB;
constexpr size_t WS_SS2 = 64 * 1024, WS_GT = 256 * 1024, WS_RS1 = 512 * 1024;
constexpr size_t WS_W1T = 1 * MiB, WS_W2T = 10 * MiB, WS_W3T = 12 * MiB, WS_W4T = 17 * MiB, WS_AB = 19 * MiB;
constexpr size_t WS_XB = 21 * MiB, WS_QK = 21 * MiB, WS_H1B = 21 * MiB;
constexpr size_t WS_QKV = 55 * MiB, WS_A2 = 55 * MiB, WS_A3 = 55 * MiB;
constexpr size_t WS_H1 = 88 * MiB, WS_ORAW = 88 * MiB;
constexpr size_t WS_GATE = 152 * MiB, WS_KVQG = 153 * MiB;
constexpr size_t WS_KDT = 185 * MiB, WS_UT = 217 * MiB;
constexpr size_t WS_END = 249 * MiB;
constexpr int LDS_BYTES = 152 * 1024;

struct Params { const float* in[21]; float* out; unsigned char* ws; int ph_lo, ph_hi; };

DEV float bf2f(unsigned short b) { return __uint_as_float((unsigned)b << 16); }
DEV float bf2f(short b) { return __uint_as_float(((unsigned)(unsigned short)b) << 16); }
typedef __bf16 bf16x2_t __attribute__((ext_vector_type(2)));
typedef float f32x2_t __attribute__((ext_vector_type(2)));
DEV unsigned cvt_pk(float lo, float hi) { f32x2_t v = {lo, hi}; return __builtin_bit_cast(unsigned, __builtin_convertvector(v, bf16x2_t)); }
DEV float sigm(float x) { return __builtin_amdgcn_rcpf(1.f + __expf(-x)); }
DEV float silu(float x) { return x * __builtin_amdgcn_rcpf(1.f + __expf(-x)); }
DEV f32x4 mfma16(bf16x8 a, bf16x8 b, f32x4 c) { return __builtin_amdgcn_mfma_f32_16x16x32_bf16(a, b, c, 0, 0, 0); }
DEV float wave_sum(float v) {
#pragma unroll
    for (int o = 1; o < 64; o <<= 1) v += __shfl_xor(v, o);
    return v;
}
DEV float wave_max(float v) {
#pragma unroll
    for (int o = 1; o < 64; o <<= 1) v = fmaxf(v, __shfl_xor(v, o));
    return v;
}
DEV bf16x8 pack8(const float* v) { u32x4 w; w.x = cvt_pk(v[0], v[1]); w.y = cvt_pk(v[2], v[3]); w.z = cvt_pk(v[4], v[5]); w.w = cvt_pk(v[6], v[7]); return __builtin_bit_cast(bf16x8, w); }
DEV bf16x8 pack44(f32x4 a, f32x4 b) { u32x4 w; w.x = cvt_pk(a[0], a[1]); w.y = cvt_pk(a[2], a[3]); w.z = cvt_pk(b[0], b[1]); w.w = cvt_pk(b[2], b[3]); return __builtin_bit_cast(bf16x8, w); }
DEV u32x2 pack4(f32x4 a) { u32x2 w; w.x = cvt_pk(a[0], a[1]); w.y = cvt_pk(a[2], a[3]); return w; }
DEV s16x4 ldstr(const LAS bf16_t* X, int stride, int row0, int col0, int fr) {
    const LAS bf16_t* p = X + (row0 + (fr >> 2)) * stride + col0 + 4 * (fr & 3);
    return __builtin_bit_cast(s16x4, __builtin_amdgcn_ds_read_tr16_b64_v4i16((LAS v4i16_t*)p));
}
DEV bf16x8 cat4(s16x4 a, s16x4 b) { bf16x8 r; r[0] = a[0]; r[1] = a[1]; r[2] = a[2]; r[3] = a[3]; r[4] = b[0]; r[5] = b[1]; r[6] = b[2]; r[7] = b[3]; return r; }
#define BLOCK_BAR() __syncthreads()

template <int MODE> struct Epi {
    static constexpr bool PERM = true, AFTER_DRAIN = false;
    bf16_t* ob; bf16_t* ob2; float* of32; const float* res; float* ss; const float* rs; const bf16_t* resb;
    __device__ __forceinline__ void operator()(const f32x4 (&acc)[2][2][4][2], const pg8::Unit& u, int wr, int wc, int fr, int fq) const {
        const int row0 = u.pm * 256 + wr * 64 + fr, colt = u.pn * 256 + wc * 32 + 8 * fq;
        float scv[2][4];
        if constexpr (MODE == 1 || MODE == 5) {
#pragma unroll
            for (int ai = 0; ai < 2; ++ai)
#pragma unroll
                for (int m = 0; m < 4; ++m) { const int row = row0 + ai * 128 + m * 16; scv[ai][m] = (MODE == 1) ? rs[row] : ss[row]; }
        }
#pragma unroll
        for (int ai = 0; ai < 2; ++ai)
#pragma unroll
            for (int m = 0; m < 4; ++m) {
                const int row = row0 + ai * 128 + m * 16;
                if constexpr (MODE == 1 || MODE == 5) {
                    float sc;
                    if constexpr (MODE == 1) sc = scv[ai][m]; else sc = rsqrtf(scv[ai][m] * (1.f / 1024.f) + EPS);
#pragma unroll
                    for (int bj = 0; bj < 2; ++bj) {
                        const int col = colt + bj * 128;
                        const bf16x8 w = pack44(acc[ai][bj][m][0] * sc, acc[ai][bj][m][1] * sc);
                        if constexpr (MODE == 1) {
                            if (col < 3072) *(bf16x8*)(ob + (size_t)row * 3072 + col) = w; else *(bf16x8*)(ob2 + (size_t)row * 1024 + (col - 3072)) = w;
                        } else *(bf16x8*)(ob + (size_t)row * 2560 + col) = w;
                    }
                } else {
                    float sq = 0.f;
#pragma unroll
                    for (int bj = 0; bj < 2; ++bj) {
                        const size_t off = (size_t)row * 1024 + colt + bj * 128;
                        f32x4 h0, h1;
                        if constexpr (MODE == 4) { h0 = *(const f32x4*)(res + off) + acc[ai][bj][m][0]; h1 = *(const f32x4*)(res + off + 4) + acc[ai][bj][m][1]; }
                        else { const bf16x8 rb = *(const bf16x8*)(resb + off);
#pragma unroll
                            for (int j = 0; j < 4; ++j) { h0[j] = bf2f(rb[j]) + acc[ai][bj][m][0][j]; h1[j] = bf2f(rb[4 + j]) + acc[ai][bj][m][1][j]; }
                            __builtin_nontemporal_store(h0, (f32x4*)(of32 + off)); __builtin_nontemporal_store(h1, (f32x4*)(of32 + off + 4)); }
                        if constexpr (MODE == 4) {
                            *(bf16x8*)(ob + off) = pack44(h0, h1);
                            sq += (h0[0] * h0[0] + h0[1] * h0[1]) + (h0[2] * h0[2] + h0[3] * h0[3]) + (h1[0] * h1[0] + h1[1] * h1[1]) + (h1[2] * h1[2] + h1[3] * h1[3]);
                        }
                    }
                    if constexpr (MODE == 4) {
                        sq += __shfl_xor(sq, 16); sq += __shfl_xor(sq, 32);
                        if (fq == 0) __hip_atomic_fetch_add(ss + row, sq, __ATOMIC_RELAXED, __HIP_MEMORY_SCOPE_AGENT);
                    }
                }
            }
    }
};

DEV f32x4 skinny_mma(const bf16_t* A, const bf16_t* Bt, int n0, int wave, int fr, int fq, unsigned char* lds) {
    LAS float* red = (LAS float*)lds;
    const int lane = fr + 16 * fq;
    bf16x8 x[4], a[8][4];
#pragma unroll
    for (int ks = 0; ks < 4; ++ks) x[ks] = *(const bf16x8*)(Bt + (size_t)(n0 + fr) * 1024 + 128 * wave + 32 * ks + 8 * fq);
#pragma unroll
    for (int rt = 0; rt < 8; ++rt)
#pragma unroll
        for (int ks = 0; ks < 4; ++ks) a[rt][ks] = *(const bf16x8*)(A + (size_t)(16 * rt + fr) * 1024 + 128 * wave + 32 * ks + 8 * fq);
#pragma unroll
    for (int rt = 0; rt < 8; ++rt) { f32x4 acc = {0.f, 0.f, 0.f, 0.f};
#pragma unroll
        for (int ks = 0; ks < 4; ++ks) acc = mfma16(x[ks], a[rt][ks], acc);
        *(LAS f32x4*)(red + ((rt * 8 + wave) * 64 + lane) * 4) = acc; }
    __syncthreads();
    f32x4 sum = {0.f, 0.f, 0.f, 0.f};
#pragma unroll
    for (int w2 = 0; w2 < 8; ++w2) sum += *(const LAS f32x4*)(red + ((wave * 8 + w2) * 64 + lane) * 4);
    __syncthreads();
    return sum;
}

DEV void transpose_item(const float* W, const float* gain, int K, int N, bf16_t* WT, int row_off, LAS float* scr, int item, int lane) {
    const int nblk = (N + 31) / 32, kb = item / nblk, nb = item % nblk, k0 = 64 * kb, n0 = 32 * nb;
    const int n = n0 + (lane & 31);
    float wv[32];
    const int ncl = n < N ? n : N - 1;
#pragma unroll
    for (int i = 0; i < 32; ++i) wv[i] = __builtin_nontemporal_load(W + (size_t)(k0 + 2 * i + (lane >> 5)) * N + ncl);
#pragma unroll
    for (int i = 0; i < 32; ++i) {
        const int kk = 2 * i + (lane >> 5);
        float v = (n < N) ? wv[i] : 0.f;
        if (gain) v *= gain[k0 + kk];
        scr[kk * 33 + (lane & 31)] = v;
    }
    asm volatile("s_waitcnt lgkmcnt(0)" ::: "memory");
    const int c = lane & 7;
#pragma unroll
    for (int j = 0; j < 4; ++j) {
        const int nn = (lane >> 3) + 8 * j; const LAS float* s = scr + (8 * c) * 33 + nn;
        u32x4 o; o.x = cvt_pk(s[0 * 33], s[1 * 33]); o.y = cvt_pk(s[2 * 33], s[3 * 33]); o.z = cvt_pk(s[4 * 33], s[5 * 33]); o.w = cvt_pk(s[6 * 33], s[7 * 33]);
        if (n0 + nn < N) *(u32x4*)(WT + (size_t)(row_off + n0 + nn) * K + k0 + 8 * c) = o;
    }
    asm volatile("s_waitcnt lgkmcnt(0)" ::: "memory");
}

DEV void phase0(const Params& p, unsigned char* lds, int lane, int wave, int G, int bid) {
    LAS float* scr = (LAS float*)lds + wave * 2176;
    const int gw = bid * 8 + wave, NGW = G * 8;
    bf16_t* W1T = (bf16_t*)(p.ws + WS_W1T); bf16_t* W2T = (bf16_t*)(p.ws + WS_W2T); bf16_t* W3T = (bf16_t*)(p.ws + WS_W3T); bf16_t* W4T = (bf16_t*)(p.ws + WS_W4T);
    constexpr int I1 = 16 * 129, I2 = 16 * 32, I3A = 16 * 16, I3B = 16 * 64, I4 = 16 * 32, NITEMS = I1 + I2 + I3A + I3B + I4;
    for (int it = gw; it < NITEMS; it += NGW) {
        int r = it;
        if (r < I1) { transpose_item(p.in[7], p.in[6], 1024, 4112, W1T, 0, scr, r, lane); continue; } r -= I1;
        if (r < I2) { transpose_item(p.in[12], nullptr, 1024, 1024, W2T, 0, scr, r, lane); continue; } r -= I2;
        if (r < I3A) { transpose_item(p.in[14], p.in[13], 1024, 512, W3T, 0, scr, r, lane); continue; } r -= I3A;
        if (r < I3B) { transpose_item(p.in[17], p.in[16], 1024, 2048, W3T, 512, scr, r, lane); continue; } r -= I3B;
        transpose_item(p.in[20], nullptr, 1024, 1024, W4T, 0, scr, r, lane);
    }
    bf16_t* XB = (bf16_t*)(p.ws + WS_XB); float* RS1 = (float*)(p.ws + WS_RS1); float* AB = (float*)(p.ws + WS_AB);
    { float* SS2 = (float*)(p.ws + WS_SS2); for (int i = gw * 64 + lane; i < NR; i += NGW * 64) SS2[i] = 0.f; }
    LAS float* wab = (LAS float*)((LAS unsigned char*)lds + 73728);
    {
        float wv[32], gv[32];
#pragma unroll
        for (int q = 0; q < 32; ++q) { const int i = threadIdx.x + 512 * q, k = i >> 4, c = i & 15; wv[q] = p.in[7][(size_t)k * 4112 + 4096 + c]; gv[q] = p.in[6][k]; }
#pragma unroll
        for (int q = 0; q < 32; ++q) { const int i = threadIdx.x + 512 * q, k = i >> 4, c = i & 15;
            wab[((((k >> 8) * 4 + (k & 3)) * 4 + (c >> 2)) * 64 + ((k >> 2) & 63)) * 4 + (c & 3)] = wv[q] * gv[q]; }
    }
    __syncthreads();
#pragma unroll 1
    for (int m0 = 4 * gw; m0 < NR; m0 += 4 * NGW) {
        f32x4 v[4][4]; float rs[4];
#pragma unroll
        for (int r = 0; r < 4; ++r) {
            const int m = m0 + r;
            const float* xrow = (m < NP) ? p.in[0] + (size_t)m * 1024 : p.in[1] + (size_t)(m - NP) * 1024;
            const f32x4* xr = (const f32x4*)xrow + lane; float s = 0.f;
#pragma unroll
            for (int j = 0; j < 4; ++j) { v[r][j] = xr[64 * j]; s += (v[r][j][0] * v[r][j][0] + v[r][j][1] * v[r][j][1]) + (v[r][j][2] * v[r][j][2] + v[r][j][3] * v[r][j][3]); }
            rs[r] = rsqrtf(wave_sum(s) * (1.f / 1024.f) + EPS);
            if (lane == 0) RS1[m] = rs[r];
            u32x2* o8 = (u32x2*)(XB + (size_t)m * 1024) + lane;
#pragma unroll
            for (int j = 0; j < 4; ++j) o8[64 * j] = pack4(v[r][j]);
        }
        float acc[64];
#pragma unroll
        for (int i = 0; i < 64; ++i) acc[i] = 0.f;
#pragma unroll
        for (int j = 0; j < 4; ++j)
#pragma unroll
            for (int e = 0; e < 4; ++e)
#pragma unroll
                for (int c4 = 0; c4 < 4; ++c4) { const f32x4 w = *(const LAS f32x4*)(wab + (((j * 4 + e) * 4 + c4) * 64 + lane) * 4);
#pragma unroll
                    for (int r = 0; r < 4; ++r)
#pragma unroll
                        for (int ci = 0; ci < 4; ++ci) acc[r * 16 + c4 * 4 + ci] += v[r][j][e] * w[ci];
                    if (c4 == 3) __builtin_amdgcn_sched_barrier(0); }
#pragma unroll
        for (int half = 32; half >= 1; half >>= 1) { const bool up = (lane & half) != 0;
#pragma unroll
            for (int i = 0; i < half; ++i) { const float snd = up ? acc[i] : acc[i + half], kp = up ? acc[i + half] : acc[i]; acc[i] = kp + __shfl_xor(snd, half); } }
        const int rr = lane >> 4; const float rsel = rr == 0 ? rs[0] : (rr == 1 ? rs[1] : (rr == 2 ? rs[2] : rs[3]));
        AB[(size_t)m0 * 16 + lane] = acc[0] * rsel;
    }
}

DEV void phase1_skinny(const Params& p, unsigned char* lds, int lane, int wave, int G, int bid) {
    const int fr = lane & 15, fq = lane >> 4;
    const bf16_t* XB = (const bf16_t*)(p.ws + WS_XB); const bf16_t* W1T = (const bf16_t*)(p.ws + WS_W1T); const float* RS1 = (const float*)(p.ws + WS_RS1);
    bf16_t* QKV = (bf16_t*)(p.ws + WS_QKV); bf16_t* GATE = (bf16_t*)(p.ws + WS_GATE);
    for (int u = bid; u < 256; u += G) {
        const int n0 = 16 * u; const int row = NP + 16 * wave + fr; const float rsv = RS1[row];
        const f32x4 acc = skinny_mma(XB + (size_t)NP * 1024, W1T, n0, wave, fr, fq, lds);
        const int col = n0 + 4 * fq; const u32x2 w = pack4(acc * rsv);
        if (col < 3072) *(u32x2*)(QKV + (size_t)row * 3072 + col) = w; else *(u32x2*)(GATE + (size_t)row * 1024 + (col - 3072)) = w;
    }
}

DEV void conv_frag(const bf16x8 (&x)[4], const LAS bf16_t* wl, int t, float (&out)[8]) {
    float a8[8];
#pragma unroll
    for (int j = 0; j < 8; ++j) a8[j] = 0.f;
#pragma unroll
    for (int i = 0; i < 4; ++i) {
        const float ok = (t - 3 + i) >= 0 ? 1.f : 0.f;
        const bf16x8 w = *(const LAS bf16x8*)(wl + i * 384);
#pragma unroll
        for (int j = 0; j < 8; ++j) a8[j] += (bf2f(w[j]) * ok) * bf2f(x[i][j]);
    }
#pragma unroll
    for (int j = 0; j < 8; ++j) out[j] = silu(a8[j]);
}
DEV void conv_load(const bf16_t* QKV, int b, int t, int cb, bf16x8 (&x)[4]) {
#pragma unroll
    for (int i = 0; i < 4; ++i) { const int tt = t - 3 + i; x[i] = *(const bf16x8*)(QKV + ((size_t)b * 4096 + (tt > 0 ? tt : 0)) * 3072 + cb); }
}
constexpr int P2_HALF = 73728;
DEV void phase2(const Params& p, unsigned char* lds, int tid, int lane, int wave, int G, int bid) {
    const int hb = wave >> 2, w4 = wave & 3;
    LAS unsigned char* L = (LAS unsigned char*)lds + hb * P2_HALF;
    LAS bf16_t* KT = (LAS bf16_t*)L;
    LAS bf16_t* VT = (LAS bf16_t*)(L + 18432);
    LAS float* Ms = (LAS float*)(L + 36864);
    LAS bf16_t* TW = (LAS bf16_t*)(L + 54272);
    LAS bf16_t* TU = (LAS bf16_t*)(L + 63488);
    LAS float* GB = (LAS float*)(L + 72704);
    const float* conv_w = p.in[8]; const float* a_log = p.in[9]; const float* dt_bias = p.in[10];
    const bf16_t* QKV = (const bf16_t*)(p.ws + WS_QKV); const float* AB = (const float*)(p.ws + WS_AB);
    float* GT = (float*)(p.ws + WS_GT);
    bf16_t* Wg = (bf16_t*)(p.out + O_YP); bf16_t* QDg = (bf16_t*)((unsigned char*)(p.out + O_YP) + 32 * MiB);
    bf16_t* KDTg = (bf16_t*)(p.ws + WS_KDT); bf16_t* UTg = (bf16_t*)(p.ws + WS_UT); bf16_t* QKg = (bf16_t*)(p.ws + WS_QK);
    LAS bf16_t* wl = (LAS bf16_t*)((LAS unsigned char*)lds + 2 * P2_HALF) + hb * 1536;
    { const int h0 = (2 * bid + hb) & 7, t4 = (wave & 3) * 64 + lane;
        for (int i = t4; i < 1536; i += 256) { const int tap = i / 384, c = i % 384; wl[i] = (bf16_t)(cvt_pk(conv_w[tap * 3072 + (c >> 7) * 1024 + h0 * 128 + (c & 127)], 0.f) & 0xffffu); } }
    const float dtb_h = dt_bias[(2 * bid + hb) & 7], nalog_h = -expf(a_log[(2 * bid + hb) & 7]);
#define P2_GBETA(uu, dst) do { const int u_ = (uu); const size_t r_ = (size_t)(u_ >> 9) * 4096 + ((u_ >> 3) & 63) * 64 + lane; \
        const float a_ = AB[r_ * 16 + (u_ & 7)], bl_ = AB[r_ * 16 + 8 + (u_ & 7)]; \
        const float x_ = a_ + dtb_h; const float sp_ = x_ > 20.f ? x_ : log1pf(expf(x_)); float g_ = nalog_h * sp_; \
        _Pragma("unroll") for (int o_ = 1; o_ < 64; o_ <<= 1) { const float t_ = __shfl_up(g_, o_); if (lane >= o_) g_ += t_; } \
        (dst)[lane] = g_; (dst)[64 + lane] = 1.f / (1.f + expf(-bl_)); if (lane == 63) GT[u_] = expf(g_); } while (0)
    if (w4 == 1) P2_GBETA(2 * bid + hb, GB);
    BLOCK_BAR();
    for (int idx = bid * 512 + tid; idx < 36864; idx += G * 512) { const int b = idx / 9216, r = (idx % 9216) / 3072, c = idx % 3072;
        p.out[O_CONVP + idx] = bf2f(QKV[(size_t)(b * 4096 + 4093 + r) * 3072 + c]); }
    for (int k = 0; 2 * (bid + k * G) < 2048; ++k) {
        int lane_ = lane; asm volatile("" : "+v"(lane_));
        const int fr = lane_ & 15, fq = lane_ >> 4;
        const int u = 2 * (bid + k * G) + hb;
        const int h = u & 7, n = (u >> 3) & 63, b = u >> 9, t0 = n * 64;
        const size_t rowb = (size_t)b * 4096 + t0;
        LAS float* Gs = GB + (k & 1) * 128; LAS float* Bs = Gs + 64;
        const int tl = 16 * w4 + fr, t = t0 + tl;
        const float Gi = Gs[tl], eGi = __expf(Gi), betai = Bs[tl];
        bf16x8 Qf[4]; int pin = 0;
#pragma unroll
        for (int si = 0; si < 2; ++si) {
            const int sel = 1 - si;
            float vals[4][8]; float ss = 0.f;
            bf16x8 xr[4][4];
#pragma unroll
            for (int ks = 0; ks < 4; ++ks) conv_load(QKV, b, t, sel * 1024 + h * 128 + 32 * ks + 8 * fq + pin, xr[ks]);
#pragma unroll
            for (int ks = 0; ks < 4; ++ks) {
                conv_frag(xr[ks], wl + sel * 128 + 32 * ks + 8 * fq, t, vals[ks]);
#pragma unroll
                for (int j = 0; j < 8; ++j) ss += vals[ks][j] * vals[ks][j];
            }
            asm volatile("" : "+v"(pin), "+v"(vals[3][0]));
            ss += __shfl_xor(ss, 16); ss += __shfl_xor(ss, 32);
            float r = rsqrtf(ss + EPS); if (sel == 0) r *= 0.08838834764831845f;
#pragma unroll
            for (int ks = 0; ks < 4; ++ks) {
#pragma unroll
                for (int j = 0; j < 8; ++j) vals[ks][j] *= r;
                const bf16x8 f = pack8(vals[ks]);
                if (sel == 1) { *(LAS bf16x8*)(KT + tl * 144 + 32 * ks + 8 * fq) = f; }
                else {
                    Qf[ks] = f;
                    f32x4 lo, hi;
#pragma unroll
                    for (int j = 0; j < 4; ++j) { lo[j] = vals[ks][j] * eGi; hi[j] = vals[ks][4 + j] * eGi; }
                    bf16_t* qd = QDg + (size_t)u * 8192 + ((w4 * 4 + ks) * 64 + fr + 32 * (fq & 1)) * 8 + 4 * (fq >> 1);
                    *(u32x2*)qd = pack4(lo); *(u32x2*)(qd + 16 * 8) = pack4(hi);
                }
            }
        }
        BLOCK_BAR();
        bf16x8 Kf[4];
#pragma unroll
        for (int ks = 0; ks < 4; ++ks) Kf[ks] = *(const LAS bf16x8*)(KT + tl * 144 + 32 * ks + 8 * fq);
#pragma unroll 1
        for (int jt = 0; jt < 4; ++jt) {
            bf16_t* qkp = QKg + (size_t)u * 4096 + ((w4 * 2 + (jt >> 1)) * 64 + fr + 16 * fq) * 8 + 4 * (jt & 1);
            if (jt <= w4) {
                f32x4 c1 = {0.f, 0.f, 0.f, 0.f}, c2 = c1;
#pragma unroll
                for (int ks = 0; ks < 4; ++ks) { const bf16x8 a = *(const LAS bf16x8*)(KT + (16 * jt + fr) * 144 + 32 * ks + 8 * fq); c1 = mfma16(a, Kf[ks], c1); c2 = mfma16(a, Qf[ks], c2); }
                const f32x4 Gj = *(const LAS f32x4*)(Gs + 16 * jt + 4 * fq);
                f32x4 qv;
#pragma unroll
                for (int r = 0; r < 4; ++r) { const int j = 16 * jt + 4 * fq + r; const float dec = __expf(fminf(Gi - Gj[r], 0.f));
                    Ms[j * 68 + tl] = (tl > j) ? betai * c1[r] * dec : 0.f; qv[r] = (tl >= j) ? c2[r] * dec : 0.f; }
                *(u32x2*)qkp = pack4(qv);
            } else { u32x2 z; z.x = 0u; z.y = 0u; *(u32x2*)qkp = z; }
        }
        BLOCK_BAR();
        if (w4 == 0) {
            LAS float* X = (LAS float*)VT;
            const float su = Bs[lane], sw = su * __expf(Gs[lane]);
#pragma unroll 1
            for (int ib = 0; ib < 4; ++ib) {
                float acc[16];
#pragma unroll
                for (int r = 0; r < 16; ++r) acc[r] = (lane == 16 * ib + r) ? 1.f : 0.f;
#pragma unroll 8
                for (int j = 0; j < 16 * ib; ++j) {
                    const float xj = X[j * 64 + lane];
#pragma unroll
                    for (int q = 0; q < 4; ++q) { const f32x4 mc = *(const LAS f32x4*)(Ms + j * 68 + 16 * ib + 4 * q);
#pragma unroll
                        for (int e = 0; e < 4; ++e) acc[4 * q + e] -= mc[e] * xj; }
                }
#pragma unroll
                for (int r = 0; r < 16; ++r) {
                    const float xr = acc[r]; const int j = 16 * ib + r;
#pragma unroll
                    for (int q = 0; q < 4; ++q) if (4 * q + 3 > r) { const f32x4 mc = *(const LAS f32x4*)(Ms + j * 68 + 16 * ib + 4 * q);
#pragma unroll
                        for (int e = 0; e < 4; ++e) if (4 * q + e > r) acc[4 * q + e] -= mc[e] * xr; }
                }
#pragma unroll
                for (int r = 0; r < 16; ++r) { const float xr = acc[r]; const int j = 16 * ib + r;
                    X[j * 64 + lane] = xr;
                    TW[j * 72 + lane] = (bf16_t)(cvt_pk(xr * sw, 0.f) & 0xffffu); TU[j * 72 + lane] = (bf16_t)(cvt_pk(xr * su, 0.f) & 0xffffu); }
            }
        } else {
            const float Glast = Gs[63];
            if (w4 == 1) { const int un = 2 * (bid + (k + 1) * G) + hb; if (un < 2048) P2_GBETA(un, GB + ((k + 1) & 1) * 128); }
            for (int it = (w4 - 1) * 64 + lane; it < 2048; it += 192) {
                const int d = it & 127, jg = it >> 7;
                const f32x4 Gj = *(const LAS f32x4*)(Gs + 4 * jg);
                f32x4 v;
#pragma unroll
                for (int r = 0; r < 4; ++r) v[r] = bf2f(KT[(4 * jg + r) * 144 + d]) * __expf(Glast - Gj[r]);
                *(u32x2*)(KDTg + (size_t)u * 8192 + (((d >> 4) * 2 + (jg >> 3)) * 64 + (d & 15) + 16 * (jg & 3)) * 8 + 4 * ((jg >> 2) & 1)) = pack4(v);
            }
        }
        BLOCK_BAR();
        { bf16x8 xr[4][4];
#pragma unroll
            for (int ks = 0; ks < 4; ++ks) conv_load(QKV, b, t, 2048 + h * 128 + 32 * ks + 8 * fq + pin, xr[ks]);
#pragma unroll
            for (int ks = 0; ks < 4; ++ks) { float vv[8]; conv_frag(xr[ks], wl + 256 + 32 * ks + 8 * fq, t, vv); *(LAS bf16x8*)(VT + tl * 144 + 32 * ks + 8 * fq) = pack8(vv); } }
        BLOCK_BAR();
        {
            f32x4 aw[2][4], au[4][2];
#pragma unroll
            for (int a = 0; a < 2; ++a)
#pragma unroll
                for (int c = 0; c < 4; ++c) { aw[a][c] = (f32x4){0.f, 0.f, 0.f, 0.f}; au[c][a] = aw[a][c]; }
#pragma unroll
            for (int ks = 0; ks < 2; ++ks) {
                bf16x8 Bw[4], Au[4];
#pragma unroll
                for (int it = 0; it < 4; ++it) { Bw[it] = *(const LAS bf16x8*)(TW + (16 * it + fr) * 72 + 32 * ks + 8 * fq); Au[it] = *(const LAS bf16x8*)(TU + (16 * it + fr) * 72 + 32 * ks + 8 * fq); }
#pragma unroll
                for (int tt = 0; tt < 2; ++tt) {
                    const int ct = 16 * (2 * w4 + tt);
                    const bf16x8 Ak = cat4(ldstr(KT, 144, 32 * ks + 8 * fq, ct, fr), ldstr(KT, 144, 32 * ks + 8 * fq + 4, ct, fr));
                    const bf16x8 Bv = cat4(ldstr(VT, 144, 32 * ks + 8 * fq, ct, fr), ldstr(VT, 144, 32 * ks + 8 * fq + 4, ct, fr));
#pragma unroll
                    for (int it = 0; it < 4; ++it) { aw[tt][it] = mfma16(Ak, Bw[it], aw[tt][it]); au[it][tt] = mfma16(Au[it], Bv, au[it][tt]); }
                }
            }
#pragma unroll
            for (int it = 0; it < 4; ++it) {
                *(bf16x8*)(Wg + (size_t)u * 8192 + ((it * 4 + w4) * 64 + fr + 16 * fq) * 8) = pack44(aw[0][it], aw[1][it]);
#pragma unroll
                for (int tt = 0; tt < 2; ++tt) *(u32x2*)(UTg + (size_t)u * 8192 + (((2 * w4 + tt) * 4 + it) * 64 + fr + 16 * fq) * 4) = pack4(au[it][tt]);
            }
        }
        BLOCK_BAR();
    }
}

struct ScanStage { bf16x8 a1[4]; bf16x8 a2[2]; bf16x8 kd[2]; u32x2 u; float gt; };
DEV void phase3_scan(const Params& p, unsigned char* lds, int lane, int wave, int bid) {
    const int fr = lane & 15, fq = lane >> 4;
    const int xc = bid & 7, yc = bid >> 3, bh = 4 * xc + (yc >> 3), sl = yc & 7, b = bh >> 3, h = bh & 7, e0 = 16 * sl;
    LAS bf16_t* SbL = (LAS bf16_t*)lds;
    LAS bf16_t* VbL = SbL + 4 * 64 * 8;
    const int m = wave & 3, dt = wave; const bool lo = wave < 4;
    const bf16_t* A1g = lo ? (const bf16_t*)(p.out + O_YP) : (const bf16_t*)((const unsigned char*)(p.out + O_YP) + 32 * MiB);
    const bf16_t* KDTg = (const bf16_t*)(p.ws + WS_KDT); const bf16_t* UTg = (const bf16_t*)(p.ws + WS_UT); const bf16_t* QKg = (const bf16_t*)(p.ws + WS_QK);
    const float* GT = (const float*)(p.ws + WS_GT); bf16_t* ORAW = (bf16_t*)(p.ws + WS_ORAW);
    LAS bf16_t* sbw = SbL + ((dt >> 1) * 64 + lane) * 8 + 4 * (dt & 1);
    LAS bf16_t* vbw = VbL + ((m >> 1) * 64 + lane) * 8 + 4 * (m & 1);
    f32x4 S = {0.f, 0.f, 0.f, 0.f};
    { u32x2 z; z.x = 0u; z.y = 0u; *(LAS u32x2*)sbw = z; }
    ScanStage st[4];
#define P3_LOAD(sg, nn) do { const size_t u_ = (size_t)((b * 64 + (nn)) * 8 + h); \
        _Pragma("unroll") for (int ks_ = 0; ks_ < 4; ++ks_) sg.a1[ks_] = *(const bf16x8*)(A1g + u_ * 8192 + ((m * 4 + ks_) * 64 + lane) * 8); \
        _Pragma("unroll") for (int k2_ = 0; k2_ < 2; ++k2_) { sg.a2[k2_] = *(const bf16x8*)(QKg + u_ * 4096 + ((m * 2 + k2_) * 64 + lane) * 8); \
            sg.kd[k2_] = *(const bf16x8*)(KDTg + u_ * 8192 + ((dt * 2 + k2_) * 64 + lane) * 8); } \
        sg.u = *(const u32x2*)(UTg + u_ * 8192 + ((sl * 4 + m) * 64 + lane) * 4); sg.gt = GT[u_]; } while (0)
#define P3_BODY(sg, nn, sn, nnext) do { \
        BLOCK_BAR(); \
        { const int nx_ = (nnext) < 64 ? (nnext) : 63; P3_LOAD(sn, nx_); } \
        f32x4 acc = {0.f, 0.f, 0.f, 0.f}; \
        _Pragma("unroll") for (int ks_ = 0; ks_ < 4; ++ks_) acc = mfma16(sg.a1[ks_], *(const LAS bf16x8*)(SbL + (ks_ * 64 + lane) * 8), acc); \
        if (lo) { f32x4 uv; uv[0] = __uint_as_float(sg.u.x << 16); uv[1] = __uint_as_float(sg.u.x & 0xffff0000u); uv[2] = __uint_as_float(sg.u.y << 16); uv[3] = __uint_as_float(sg.u.y & 0xffff0000u); \
            *(LAS u32x2*)vbw = pack4(uv - acc); } \
        BLOCK_BAR(); \
        const bf16x8 vb0 = *(const LAS bf16x8*)(VbL + lane * 8), vb1 = *(const LAS bf16x8*)(VbL + (64 + lane) * 8); \
        if (!lo) { acc = mfma16(sg.a2[0], vb0, acc); acc = mfma16(sg.a2[1], vb1, acc); ow[(nn) & 7] = pack4(acc); } \
        S = S * sg.gt; S = mfma16(sg.kd[0], vb0, S); S = mfma16(sg.kd[1], vb1, S); \
        *(LAS u32x2*)sbw = pack4(S); } while (0)
    P3_LOAD(st[0], 0); P3_LOAD(st[1], 1); P3_LOAD(st[2], 2);
#pragma unroll 1
    for (int n0 = 0; n0 < 64; n0 += 8) {
        u32x2 ow[8];
#pragma unroll
        for (int q = 0; q < 2; ++q) {
            const int n = n0 + 4 * q;
            P3_BODY(st[0], 4 * q, st[3], n + 3);
            P3_BODY(st[1], 4 * q + 1, st[0], n + 4);
            P3_BODY(st[2], 4 * q + 2, st[1], n + 5);
            P3_BODY(st[3], 4 * q + 3, st[2], n + 6);
        }
        if (!lo) {
#pragma unroll
            for (int q = 0; q < 8; ++q) { bf16_t* op = ORAW + ((size_t)b * 4096 + (n0 + q) * 64 + 16 * m + 4 * fq) * 1024 + h * 128 + e0 + fr;
                op[0] = (bf16_t)(ow[q].x & 0xffffu); op[1024] = (bf16_t)(ow[q].x >> 16); op[2048] = (bf16_t)(ow[q].y & 0xffffu); op[3072] = (bf16_t)(ow[q].y >> 16); }
        }
    }
#undef P3_LOAD
#undef P3_BODY
    float* so = p.out + O_SSMP + (size_t)(b * 8 + h) * 16384;
#pragma unroll
    for (int r = 0; r < 4; ++r) so[(16 * dt + 4 * fq + r) * 128 + e0 + fr] = S[r];
}

DEV void phase4_onorm(const Params& p, int tid, int G, int bid) {
    const bf16_t* ORAW = (const bf16_t*)(p.ws + WS_ORAW); const bf16_t* GATE = (const bf16_t*)(p.ws + WS_GATE); const float* o_norm = p.in[11];
    bf16_t* A2 = (bf16_t*)(p.ws + WS_A2);
    const int part = tid & 15;
    const f32x4 n0 = *(const f32x4*)(o_norm + 8 * part), n1 = *(const f32x4*)(o_norm + 8 * part + 4);
#pragma unroll 1
    for (int it0 = bid * 512 + tid; it0 < NP * 8 * 16; it0 += 8 * G * 512) {
      bf16x8 o8v[8], g8v[8];
#pragma unroll
      for (int q = 0; q < 8; ++q) { const size_t off = (size_t)((it0 + q * G * 512) >> 4) * 128 + 8 * part; o8v[q] = __builtin_nontemporal_load((const bf16x8*)(ORAW + off)); g8v[q] = __builtin_nontemporal_load((const bf16x8*)(GATE + off)); }
#pragma unroll
      for (int q = 0; q < 8; ++q) {
        const size_t off = (size_t)((it0 + q * G * 512) >> 4) * 128 + 8 * part;
        const bf16x8 o8 = o8v[q], g8 = g8v[q];
        float ov[8]; float ss = 0.f;
#pragma unroll
        for (int j = 0; j < 8; ++j) { ov[j] = bf2f(o8[j]); ss += ov[j] * ov[j]; }
        ss += __shfl_xor(ss, 1); ss += __shfl_xor(ss, 2); ss += __shfl_xor(ss, 4); ss += __shfl_xor(ss, 8);
        const float rr = rsqrtf(ss * (1.f / 128.f) + EPS);
#pragma unroll
        for (int j = 0; j < 8; ++j) ov[j] = ov[j] * rr * (j < 4 ? n0[j] : n1[j - 4]) * silu(bf2f(g8[j]));
        *(bf16x8*)(A2 + off) = pack8(ov);
      }
    }
}

DEV void phase3_sample(const Params& p, unsigned char* lds, int tid, int lane, int wave, int G, int bid) {
    const int nb = G, sb = bid;
    LAS float* qs = (LAS float*)lds; LAS float* ksm = qs + 128; LAS float* vs = ksm + 128; LAS float* sc = vs + 128; LAS float* part = sc + 16; LAS float* vnew = part + 4096; LAS float* osm = vnew + 128;
    const float* state_conv = p.in[2]; const float* state_ssm = p.in[3]; const float* conv_w = p.in[8]; const float* a_log = p.in[9]; const float* dt_bias = p.in[10]; const float* o_norm = p.in[11];
    const bf16_t* QKV = (const bf16_t*)(p.ws + WS_QKV); const float* AB = (const float*)(p.ws + WS_AB); const bf16_t* GATE = (const bf16_t*)(p.ws + WS_GATE);
    bf16_t* A2 = (bf16_t*)(p.ws + WS_A2);
    for (int u = sb; u < 1024; u += nb) {
        const int s = u >> 3, h = u & 7; const size_t row = NP + s;
        const int dgrp = tid >> 5, e4 = tid & 31;
        const float* S0 = state_ssm + (size_t)(s * 8 + h) * 16384;
        f32x4 s0[8];
#pragma unroll
        for (int i = 0; i < 8; ++i) s0[i] = __builtin_nontemporal_load((const f32x4*)(S0 + (dgrp * 8 + i) * 128 + 4 * e4));
        const float a = AB[row * 16 + h], bl = AB[row * 16 + 8 + h], dtb = dt_bias[h], alg = a_log[h];
        if (tid < 384) {
            const int sel = tid >> 7, d = tid & 127, c = sel * 1024 + h * 128 + d;
            const float b0 = state_conv[(size_t)(s * 3 + 0) * 3072 + c], b1 = state_conv[(size_t)(s * 3 + 1) * 3072 + c], b2 = state_conv[(size_t)(s * 3 + 2) * 3072 + c];
            const float uu = bf2f(QKV[row * 3072 + c]);
            float* cs = p.out + O_CONVS + (size_t)s * 9216 + c; cs[0] = b1; cs[3072] = b2; cs[6144] = uu;
            const float o = silu(conv_w[c] * b0 + conv_w[3072 + c] * b1 + conv_w[6144 + c] * b2 + conv_w[9216 + c] * uu);
            (sel == 0 ? qs : (sel == 1 ? ksm : vs))[d] = o;
        }
        BLOCK_BAR();
        if (wave < 3) {
            const float q0 = qs[lane], q1 = qs[lane + 64], k0 = ksm[lane], k1 = ksm[lane + 64];
            float v = wave == 0 ? q0 * q0 + q1 * q1 : (wave == 1 ? k0 * k0 + k1 * k1 : q0 * k0 + q1 * k1);
            v = wave_sum(v); if (lane == 0) sc[wave] = v;
        }
        BLOCK_BAR();
        const float rq = rsqrtf(sc[0] + EPS) * 0.08838834764831845f, rk = rsqrtf(sc[1] + EPS), qk = sc[2] * rq * rk;
        const float xx = a + dtb; const float sp = xx > 20.f ? xx : log1pf(expf(xx));
        const float eg = expf(-expf(alg) * sp), beta = 1.f / (1.f + expf(-bl));
        f32x4 pk = {0.f, 0.f, 0.f, 0.f}, pq = pk;
#pragma unroll
        for (int i = 0; i < 8; ++i) { const int d = dgrp * 8 + i; pk += s0[i] * (ksm[d] * rk); pq += s0[i] * (qs[d] * rq); }
        *(LAS f32x4*)(part + dgrp * 128 + 4 * e4) = pk; *(LAS f32x4*)(part + (16 + dgrp) * 128 + 4 * e4) = pq;
        BLOCK_BAR();
        if (tid < 128) {
            float kS = 0.f, qS = 0.f;
#pragma unroll
            for (int g = 0; g < 16; ++g) { kS += part[g * 128 + tid]; qS += part[(16 + g) * 128 + tid]; }
            const float vn = beta * (vs[tid] - eg * kS);
            vnew[tid] = vn; osm[tid] = eg * qS + qk * vn;
        }
        BLOCK_BAR();
        {
            const f32x4 vn4 = *(const LAS f32x4*)(vnew + 4 * e4);
            float* So = p.out + O_SSMS + (size_t)(s * 8 + h) * 16384;
#pragma unroll
            for (int i = 0; i < 8; ++i) { const int d = dgrp * 8 + i; __builtin_nontemporal_store(s0[i] * eg + vn4 * (ksm[d] * rk), (f32x4*)(So + d * 128 + 4 * e4)); }
        }
        if (wave == 0) {
            const float o0 = osm[lane], o1 = osm[lane + 64];
            const float rr = rsqrtf(wave_sum(o0 * o0 + o1 * o1) * (1.f / 128.f) + EPS);
            const float g0 = bf2f(GATE[row * 1024 + h * 128 + lane]), g1 = bf2f(GATE[row * 1024 + h * 128 + lane + 64]);
            const float r0 = o0 * rr * o_norm[lane] * silu(g0), r1 = o1 * rr * o_norm[lane + 64] * silu(g1);
            A2[row * 1024 + h * 128 + lane] = (bf16_t)(cvt_pk(r0, 0.f) & 0xffffu); A2[row * 1024 + h * 128 + lane + 64] = (bf16_t)(cvt_pk(r1, 0.f) & 0xffffu);
        }
        BLOCK_BAR();
    }
}

DEV void window_shift(const Params& p, int tid, int nb, int sb) {
    constexpr int PER = 128 * 127 * 64;
    for (int base = sb * 512 + tid; base < 2 * PER; base += 16 * nb * 512) {
        f32x4 v[16];
#pragma unroll
        for (int q8 = 0; q8 < 16; ++q8) { const int idx = base + q8 * nb * 512;
            if (idx < 2 * PER) { const int which = idx / PER, rem = idx % PER, s = rem / (127 * 64), q = rem % (127 * 64);
                v[q8] = __builtin_nontemporal_load((const f32x4*)((which ? p.in[5] : p.in[4]) + (size_t)s * 32768 + 256 + q * 4)); } }
#pragma unroll
        for (int q8 = 0; q8 < 16; ++q8) { const int idx = base + q8 * nb * 512;
            if (idx < 2 * PER) { const int which = idx / PER, rem = idx % PER, s = rem / (127 * 64), q = rem % (127 * 64);
                __builtin_nontemporal_store(v[q8], (f32x4*)(p.out + (which ? O_VWS : O_KWS) + (size_t)s * 32768 + q * 4)); } }
    }
}

DEV void phase4_skinny(const Params& p, unsigned char* lds, int lane, int wave, int G, int bid) {
    const int fr = lane & 15, fq = lane >> 4;
    const bf16_t* A2 = (const bf16_t*)(p.ws + WS_A2); const bf16_t* W2T = (const bf16_t*)(p.ws + WS_W2T);
    bf16_t* H1B = (bf16_t*)(p.ws + WS_H1B); float* SS2 = (float*)(p.ws + WS_SS2);
    for (int u = bid; u < 64; u += G) {
        const int s = 16 * wave + fr; const size_t row = NP + s; const int col = 16 * u + 4 * fq;
        const f32x4 xres = *(const f32x4*)(p.in[1] + (size_t)s * 1024 + col);
        const f32x4 acc = skinny_mma(A2 + (size_t)NP * 1024, W2T, 16 * u, wave, fr, fq, lds);
        const f32x4 hv = xres + acc;
        *(u32x2*)(H1B + row * 1024 + col) = pack4(hv);
        float sq = (hv[0] * hv[0] + hv[1] * hv[1]) + (hv[2] * hv[2] + hv[3] * hv[3]);
        sq += __shfl_xor(sq, 16); sq += __shfl_xor(sq, 32);
        if (fq == 0) __hip_atomic_fetch_add(SS2 + row, sq, __ATOMIC_RELAXED, __HIP_MEMORY_SCOPE_AGENT);
    }
}
DEV void phase5_skinny(const Params& p, unsigned char* lds, int lane, int wave, int G, int bid) {
    const int fr = lane & 15, fq = lane >> 4;
    const bf16_t* H1B = (const bf16_t*)(p.ws + WS_H1B); const bf16_t* W3T = (const bf16_t*)(p.ws + WS_W3T); const float* SS2 = (const float*)(p.ws + WS_SS2);
    bf16_t* KVQG = (bf16_t*)(p.ws + WS_KVQG);
    for (int u = (bid >= 128 ? bid - 128 : bid + G - 128); u < 160; u += G) {
        const size_t row = NP + 16 * wave + fr; const float ssv = SS2[row];
        const f32x4 acc = skinny_mma(H1B + (size_t)NP * 1024, W3T, 16 * u, wave, fr, fq, lds);
        const float sc = rsqrtf(ssv * (1.f / 1024.f) + EPS);
        *(u32x2*)(KVQG + row * 2560 + 16 * u + 4 * fq) = pack4(acc * sc);
    }
    if (bid >= 128) window_shift(p, threadIdx.x, G - 128, bid - 128);
}
DEV void phase7_skinny(const Params& p, unsigned char* lds, int lane, int wave, int G, int bid) {
    const int fr = lane & 15, fq = lane >> 4;
    const bf16_t* A3 = (const bf16_t*)(p.ws + WS_A3); const bf16_t* W4T = (const bf16_t*)(p.ws + WS_W4T); const bf16_t* H1B = (const bf16_t*)(p.ws + WS_H1B);
    for (int u = bid; u < 64; u += G) {
        const int s = 16 * wave + fr; const size_t row = NP + s;
        const u32x2 hb = *(const u32x2*)(H1B + row * 1024 + 16 * u + 4 * fq);
        const f32x4 accv = skinny_mma(A3 + (size_t)NP * 1024, W4T, 16 * u, wave, fr, fq, lds);
        { const int col = 16 * u + 4 * fq; f32x4 hv; hv[0] = __uint_as_float(hb.x << 16); hv[1] = __uint_as_float(hb.x & 0xffff0000u); hv[2] = __uint_as_float(hb.y << 16); hv[3] = __uint_as_float(hb.y & 0xffff0000u);
            *(f32x4*)(p.out + O_YS + (size_t)s * 1024 + col) = hv + accv; }
    }
}

DEV void phase6(const Params& p, unsigned char* lds, int tid, int lane, int wave, int G, int bid) {
    const int fr = lane & 15, fq = lane >> 4;
    LAS bf16_t* Ks = (LAS bf16_t*)lds;
    LAS bf16_t* Vs = (LAS bf16_t*)((LAS unsigned char*)lds + 36864);
    LAS float* wsc = (LAS float*)((LAS unsigned char*)lds + 73728) + wave * 832;
    LAS bf16_t* Ost = (LAS bf16_t*)((LAS unsigned char*)lds + 73728) + wave * 4608;
    const bf16_t* KVQG = (const bf16_t*)(p.ws + WS_KVQG); bf16_t* A3 = (bf16_t*)(p.ws + WS_A3);
    const float* k_norm = p.in[15]; const float* q_norm = p.in[18]; const float* sinks = p.in[19];
    float qnw[16];
#pragma unroll
    for (int j = 0; j < 16; ++j) qnw[j] = q_norm[32 * (j >> 3) + 8 * fq + (j & 7)] * 0.125f;
    for (int u = bid; u < 512; u += G) {
        const int kvh = u & 3, blk = (u >> 2) & 31, b = u >> 7;
        const int qh = kvh * 4 + (wave >> 1), i0 = 64 * (wave & 1);
        const float slope = exp2f(-0.5f * (float)(qh + 1)), sink = sinks[qh];
        const bf16_t* qgbase = KVQG + ((size_t)b * 4096 + blk * 128 + i0 + fr) * 2560 + qh * 64;
        bf16x8 qc[2]; u32x2 gc[4];
#pragma unroll
        for (int ks = 0; ks < 2; ++ks) qc[ks] = *(const bf16x8*)(qgbase + 512 + 32 * ks + 8 * fq);
#pragma unroll
        for (int dt = 0; dt < 4; ++dt) gc[dt] = *(const u32x2*)(qgbase + 1536 + 16 * dt + 4 * fq);
        {
            const int r = tid >> 1, hf = tid & 1; const int tok = (blk - 1) * 128 + r;
            float kv[32]; float ss = 0.f; bf16x8 vv[4];
            if (tok >= 0) {
                const bf16_t* src = KVQG + ((size_t)b * 4096 + tok) * 2560 + kvh * 64 + 32 * hf;
#pragma unroll
                for (int q = 0; q < 4; ++q) { const bf16x8 x = *(const bf16x8*)(src + 8 * q); vv[q] = *(const bf16x8*)(src + 256 + 8 * q);
#pragma unroll
                    for (int j = 0; j < 8; ++j) { const float f = bf2f(x[j]); kv[8 * q + j] = f; ss += f * f; } }
            } else {
#pragma unroll
                for (int j = 0; j < 32; ++j) kv[j] = 0.f;
#pragma unroll
                for (int q = 0; q < 4; ++q) vv[q] = (bf16x8){0, 0, 0, 0, 0, 0, 0, 0};
            }
            ss += __shfl_xor(ss, 1);
            const float rr = rsqrtf(ss * (1.f / 64.f) + EPS);
#pragma unroll
            for (int j = 0; j < 32; ++j) kv[j] *= rr * k_norm[32 * hf + j];
#pragma unroll
            for (int q = 0; q < 4; ++q) { *(LAS bf16x8*)(Ks + r * 72 + 32 * hf + 8 * q) = pack8(kv + 8 * q); *(LAS bf16x8*)(Vs + r * 72 + 32 * hf + 8 * q) = vv[q]; }
            if (blk == 31 && r >= 128) {
                float* kd = p.out + O_KWP + ((size_t)(b * 128 + (r - 128)) * 4 + kvh) * 64 + 32 * hf; float* vd = p.out + O_VWP + ((size_t)(b * 128 + (r - 128)) * 4 + kvh) * 64 + 32 * hf;
#pragma unroll
                for (int q = 0; q < 8; ++q) *(f32x4*)(kd + 4 * q) = (f32x4){kv[4 * q], kv[4 * q + 1], kv[4 * q + 2], kv[4 * q + 3]};
#pragma unroll
                for (int q = 0; q < 4; ++q) { *(f32x4*)(vd + 8 * q) = (f32x4){bf2f(vv[q][0]), bf2f(vv[q][1]), bf2f(vv[q][2]), bf2f(vv[q][3])}; *(f32x4*)(vd + 8 * q + 4) = (f32x4){bf2f(vv[q][4]), bf2f(vv[q][5]), bf2f(vv[q][6]), bf2f(vv[q][7])}; }
            }
        }
        BLOCK_BAR();
#pragma unroll 1
        for (int qt = 0; qt < 4; ++qt) {
            const int iq = i0 + 16 * qt + fr;
            bf16x8 qn[2]; u32x2 gn[4];
            { const bf16_t* nb_ = qgbase + (size_t)(16 * (qt < 3 ? qt + 1 : 3)) * 2560;
#pragma unroll
                for (int ks = 0; ks < 2; ++ks) qn[ks] = *(const bf16x8*)(nb_ + 512 + 32 * ks + 8 * fq);
#pragma unroll
                for (int dt = 0; dt < 4; ++dt) gn[dt] = *(const u32x2*)(nb_ + 1536 + 16 * dt + 4 * fq); }
            bf16x8 Qf[2];
            {
                float qv[16]; float ss = 0.f;
#pragma unroll
                for (int ks = 0; ks < 2; ++ks) { const bf16x8 x = qc[ks];
#pragma unroll
                    for (int j = 0; j < 8; ++j) { const float f = bf2f(x[j]); qv[8 * ks + j] = f; ss += f * f; } }
                ss += __shfl_xor(ss, 16); ss += __shfl_xor(ss, 32);
                const float rr = rsqrtf(ss * (1.f / 64.f) + EPS);
#pragma unroll
                for (int ks = 0; ks < 2; ++ks) {
#pragma unroll
                    for (int j = 0; j < 8; ++j) qv[8 * ks + j] *= rr * qnw[8 * ks + j];
                    Qf[ks] = pack8(qv + 8 * ks); }
            }
            const int kts = ((i0 >> 4) + qt) & ~1;
            f32x4 st[10]; float mx = -INFINITY;
#pragma unroll
            for (int tt = 0; tt < 10; ++tt) {
                const int kt = kts + tt; f32x4 c = {0.f, 0.f, 0.f, 0.f};
#pragma unroll
                for (int ks = 0; ks < 2; ++ks) c = mfma16(*(const LAS bf16x8*)(Ks + (16 * kt + fr) * 72 + 32 * ks + 8 * fq), Qf[ks], c);
#pragma unroll
                for (int r = 0; r < 4; ++r) { const int j = 16 * kt + 4 * fq + r, dist = iq - j + 128;
                    const bool ok = dist >= 0 && dist <= 128 && (blk > 0 || j >= 128);
                    c[r] = ok ? c[r] - slope * (float)dist : -INFINITY; mx = fmaxf(mx, c[r]); }
                st[tt] = c;
            }
            mx = fmaxf(mx, __shfl_xor(mx, 16)); mx = fmaxf(mx, __shfl_xor(mx, 32)); mx = fmaxf(mx, sink);
            float sum = 0.f;
#pragma unroll
            for (int tt = 0; tt < 10; ++tt)
#pragma unroll
                for (int r = 0; r < 4; ++r) { const float e = __expf(st[tt][r] - mx); st[tt][r] = e; sum += e; }
            sum += __shfl_xor(sum, 16); sum += __shfl_xor(sum, 32);
            const float inv = 1.f / (sum + __expf(sink - mx));
            bf16x8 Pf[5];
#pragma unroll
            for (int k2 = 0; k2 < 5; ++k2) Pf[k2] = pack44(st[2 * k2], st[2 * k2 + 1]);
#pragma unroll
            for (int dt = 0; dt < 4; ++dt) {
                f32x4 o = {0.f, 0.f, 0.f, 0.f};
#pragma unroll
                for (int k2 = 0; k2 < 5; ++k2) { const int kb = 16 * (kts + 2 * k2);
                    const bf16x8 a = cat4(ldstr(Vs, 72, kb + 4 * fq, 16 * dt, fr), ldstr(Vs, 72, kb + 16 + 4 * fq, 16 * dt, fr));
                    o = mfma16(a, Pf[k2], o); }
                const u32x2 gw = gc[dt];
                f32x4 g; g[0] = __uint_as_float(gw.x << 16); g[1] = __uint_as_float(gw.x & 0xffff0000u); g[2] = __uint_as_float(gw.y << 16); g[3] = __uint_as_float(gw.y & 0xffff0000u);
#pragma unroll
                for (int r = 0; r < 4; ++r) o[r] = o[r] * inv * silu(g[r]);
                *(LAS u32x2*)(Ost + (16 * qt + fr) * 72 + 16 * dt + 4 * fq) = pack4(o);
            }
#pragma unroll
            for (int ks = 0; ks < 2; ++ks) qc[ks] = qn[ks];
#pragma unroll
            for (int dt = 0; dt < 4; ++dt) gc[dt] = gn[dt];
        }
#pragma unroll
        for (int i = 0; i < 8; ++i) { const int r = 8 * i + (lane >> 3), ch = lane & 7;
            *(bf16x8*)(A3 + ((size_t)b * 4096 + blk * 128 + i0 + r) * 1024 + qh * 64 + 8 * ch) = *(const LAS bf16x8*)(Ost + r * 72 + 8 * ch); }
        BLOCK_BAR();
    }
    for (int su = wave * G + bid; su < 512; su += 8 * G) {
        const int s = su >> 2, kvh = su & 3; const size_t row = NP + s;
        LAS float* qsm = wsc; LAS float* psm = wsc + 256;
        float kn = bf2f(KVQG[row * 2560 + kvh * 64 + lane]); const float vn = bf2f(KVQG[row * 2560 + 256 + kvh * 64 + lane]);
        kn *= rsqrtf(wave_sum(kn * kn) * (1.f / 64.f) + EPS) * k_norm[lane];
        p.out[O_KWS + ((size_t)(s * 128 + 127) * 4 + kvh) * 64 + lane] = kn; p.out[O_VWS + ((size_t)(s * 128 + 127) * 4 + kvh) * 64 + lane] = vn;
        float qg[4], snew[4];
#pragma unroll
        for (int g = 0; g < 4; ++g) { float q = bf2f(KVQG[row * 2560 + 512 + (kvh * 4 + g) * 64 + lane]);
            q *= rsqrtf(wave_sum(q * q) * (1.f / 64.f) + EPS) * q_norm[lane] * 0.125f; qg[g] = q; qsm[g * 64 + lane] = q; snew[g] = wave_sum(q * kn); }
        asm volatile("s_waitcnt lgkmcnt(0)" ::: "memory");
        const float* kc0 = p.in[4] + ((size_t)(s * 128 + lane) * 4 + kvh) * 64; const float* kc1 = kc0 + 64 * 256;
        float s0[4] = {0.f, 0.f, 0.f, 0.f}, s1[4] = {0.f, 0.f, 0.f, 0.f};
#pragma unroll 8
        for (int d4 = 0; d4 < 16; ++d4) { const f32x4 x0 = __builtin_nontemporal_load((const f32x4*)(kc0 + 4 * d4)), x1 = __builtin_nontemporal_load((const f32x4*)(kc1 + 4 * d4));
#pragma unroll
            for (int g = 0; g < 4; ++g) { const f32x4 q4 = *(const LAS f32x4*)(qsm + g * 64 + 4 * d4);
                s0[g] += (q4[0] * x0[0] + q4[1] * x0[1]) + (q4[2] * x0[2] + q4[3] * x0[3]); s1[g] += (q4[0] * x1[0] + q4[1] * x1[1]) + (q4[2] * x1[2] + q4[3] * x1[3]); } }
        float inv[4];
#pragma unroll
        for (int g = 0; g < 4; ++g) {
            const int qh = kvh * 4 + g; const float slope = exp2f(-0.5f * (float)(qh + 1)), sink = sinks[qh];
            const float a0 = s0[g] - slope * (float)(128 - lane), a1 = s1[g] - slope * (float)(64 - lane), a2 = snew[g];
            const float mx = fmaxf(fmaxf(wave_max(fmaxf(a0, a1)), a2), sink);
            const float e0 = __expf(a0 - mx), e1 = __expf(a1 - mx), e2 = __expf(a2 - mx);
            inv[g] = 1.f / (wave_sum(e0 + e1) + e2 + __expf(sink - mx));
            psm[lane * 4 + g] = e0; psm[(lane + 64) * 4 + g] = e1; if (lane == 0) psm[128 * 4 + g] = e2;
        }
        asm volatile("s_waitcnt lgkmcnt(0)" ::: "memory");
        f32x4 o4[4];
#pragma unroll
        for (int g = 0; g < 4; ++g) o4[g] = (f32x4){0.f, 0.f, 0.f, 0.f};
        const int g4 = lane >> 4, d4 = lane & 15;
        const float* vc = p.in[5] + ((size_t)(s * 128 + g4) * 4 + kvh) * 64 + 4 * d4;
#pragma unroll 16
        for (int j = 0; j < 32; ++j) { const f32x4 v = __builtin_nontemporal_load((const f32x4*)(vc + (size_t)j * 1024)); const f32x4 p4 = *(const LAS f32x4*)(psm + 4 * (4 * j + g4));
#pragma unroll
            for (int g = 0; g < 4; ++g) o4[g] += v * p4[g]; }
#pragma unroll
        for (int g = 0; g < 4; ++g)
#pragma unroll
            for (int e = 0; e < 4; ++e) { float t = o4[g][e]; t += __shfl_xor(t, 16); t += __shfl_xor(t, 32); o4[g][e] = t; }
        {
            const f32x4 p4 = *(const LAS f32x4*)(psm + 4 * 128);
            f32x4 vne4;
#pragma unroll
            for (int e = 0; e < 4; ++e) vne4[e] = __shfl(vn, 4 * d4 + e);
            if (g4 == 0) {
#pragma unroll
                for (int g = 0; g < 4; ++g) { const int qh = kvh * 4 + g;
                    const u32x2 gw = *(const u32x2*)(KVQG + row * 2560 + 1536 + qh * 64 + 4 * d4);
                    f32x4 gg; gg[0] = __uint_as_float(gw.x << 16); gg[1] = __uint_as_float(gw.x & 0xffff0000u); gg[2] = __uint_as_float(gw.y << 16); gg[3] = __uint_as_float(gw.y & 0xffff0000u);
                    f32x4 r;
#pragma unroll
                    for (int e = 0; e < 4; ++e) r[e] = (o4[g][e] + p4[g] * vne4[e]) * inv[g] * silu(gg[e]);
                    *(u32x2*)(A3 + row * 1024 + qh * 64 + 4 * d4) = pack4(r); }
            }
        }
        asm volatile("s_waitcnt lgkmcnt(0)" ::: "memory");
    }
}

#define XB_TMO      128
#define XB_XCNT(j)  (256  + 64 * (j))
#define XB_XSUB(j)  (1280 + 64 * (j))
#define XB_XGEN(j)  (2304 + 64 * (j))
#define XB_TOP      3328
#define XB_TOPGEN   3392
#define XCD_BAR_WORDS 3456
#define XB_SPIN_CAP (1u << 18)

__device__ __forceinline__ unsigned xb_ld(unsigned* p)              { return __hip_atomic_load(p, __ATOMIC_RELAXED, __HIP_MEMORY_SCOPE_AGENT); }
__device__ __forceinline__ unsigned xb_add(unsigned* p, unsigned v) { return __hip_atomic_fetch_add(p, v, __ATOMIC_RELAXED, __HIP_MEMORY_SCOPE_AGENT); }
__device__ __forceinline__ unsigned xb_xcc_id() { return (unsigned)__builtin_amdgcn_s_getreg((3 << 11) | 20) & 0xFu; }
#define XB_SPIN(cond, bar) do { unsigned _sp = 0; while (cond) { __builtin_amdgcn_s_sleep(1); \
    if ((++_sp & 255u) == 0u) { if (xb_ld(&(bar)[XB_TMO])) break; if (_sp > XB_SPIN_CAP) { atomicAdd(&(bar)[XB_TMO], 1u); break; } } } } while (0)

struct XcdBarrier {
    unsigned* bar; unsigned x;
    volatile LAS unsigned* st;
};

__device__ __forceinline__ XcdBarrier xcd_barrier_post(unsigned* bar, volatile LAS unsigned* st) {
    XcdBarrier b; b.bar = bar; b.x = xb_xcc_id(); b.st = st;
    if (threadIdx.x == 0) (void)xb_add(&bar[XB_XCNT(b.x)], 1u);
    return b;
}
__device__ __forceinline__ void xcd_barrier_complete(unsigned* bar, unsigned x, unsigned& nloc, unsigned& nx) {
    const unsigned G = gridDim.x * gridDim.y * gridDim.z;
    unsigned sum, cnt, mine, sp = 0u;
    for (;;) {
        sum = 0u; cnt = 0u; mine = 0u;
#pragma unroll
        for (unsigned j = 0; j < 16; ++j) { const unsigned c = xb_ld(&bar[XB_XCNT(j)]); sum += c; cnt += (c > 0u) ? 1u : 0u; mine = (j == x) ? c : mine; }
        if (sum == G) break;
        __builtin_amdgcn_s_sleep(1);
        if ((++sp & 255u) == 0u) { if (xb_ld(&bar[XB_TMO])) break; if (sp > XB_SPIN_CAP) { atomicAdd(&bar[XB_TMO], 1u); break; } }
    }
    nloc = mine > 0u ? mine : 1u; nx = cnt > 0u ? cnt : 1u;
}

__device__ __forceinline__ void xcd_barrier(const XcdBarrier& b) {
    asm volatile("s_waitcnt vmcnt(0)" ::: "memory");
    __syncthreads();
    if (threadIdx.x == 0) {
        unsigned* bar = b.bar;
        __builtin_amdgcn_s_waitcnt(0);
        unsigned nloc = b.st[0], nx = b.st[1];
        if (nloc == 0u) { xcd_barrier_complete(bar, b.x, nloc, nx); b.st[0] = nloc; b.st[1] = nx; }
        const unsigned old = xb_add(&bar[XB_XSUB(b.x)], 1u);
        const unsigned gen = old / nloc;
        if (old + 1u == (gen + 1u) * nloc) {
            __builtin_amdgcn_fence(__ATOMIC_RELEASE, "agent");
            asm volatile("s_waitcnt vmcnt(0)" ::: "memory");
            const unsigned og = xb_add(&bar[XB_TOP], 1u);
            const unsigned tg = og / nx;
            if (og + 1u == (tg + 1u) * nx) xb_add(&bar[XB_TOPGEN], 1u);
            else XB_SPIN(xb_ld(&bar[XB_TOPGEN]) == tg, bar);
            __builtin_amdgcn_fence(__ATOMIC_ACQUIRE, "agent");
            xb_add(&bar[XB_XGEN(b.x)], 1u);
            asm volatile("s_waitcnt vmcnt(0)" ::: "memory");
        } else {
            XB_SPIN(xb_ld(&bar[XB_XGEN(b.x)]) == gen, bar);
            __builtin_amdgcn_fence(__ATOMIC_ACQUIRE, "agent");
            asm volatile("s_waitcnt vmcnt(0)" ::: "memory");
        }
    }
    __syncthreads();
}

__global__ void __launch_bounds__(512, 2) yoco_fwd(Params p) {
    extern __shared__ __attribute__((aligned(16))) unsigned char lds[];
    cg::grid_group grid = cg::this_grid();
    const int tid = threadIdx.x, lane = tid & 63, wave = __builtin_amdgcn_readfirstlane(tid >> 6);
    const int G = gridDim.x, bid = blockIdx.x;
    const int lo = p.ph_lo, hi = p.ph_hi & 255, dbl = (p.ph_hi >> 8) - 1;
    volatile LAS unsigned* bst = (volatile LAS unsigned*)((LAS unsigned char*)lds + LDS_BYTES - 64);
    if (tid < 2) bst[tid] = 0u;
    __syncthreads();
    XcdBarrier xbar = xcd_barrier_post((unsigned*)(p.ws + WS_CTL), bst);
    if (lo < 0) grid.sync();
#define IN(k) (lo <= (k) && (k) < hi)
#define SEAM(k) do { if (IN(k) && IN((k) + 1)) xcd_barrier(xbar); } while (0)
#define RUN(k) (IN(k) ? (1 + (dbl == (k))) : 0)
    PG8_LAS unsigned char* ring = (PG8_LAS unsigned char*)lds;
    if (IN(0)) { phase0(p, lds, lane, wave, G, bid); }
    SEAM(0);
    if (IN(1)) {
        pg8::Gemm g{(const bf16_t*)(p.ws + WS_XB), (const bf16_t*)(p.ws + WS_W1T), NP, 4096, 1024}; pg8::StaticOrder S; S.init(NP, 4096, G, bid);
        Epi<1> E{(bf16_t*)(p.ws + WS_QKV), (bf16_t*)(p.ws + WS_GATE), nullptr, nullptr, nullptr, (const float*)(p.ws + WS_RS1), nullptr};
        pg8::gemm_phase<Epi<1>, pg8::StaticOrder, true, true>(ring, g, S, E);
        phase1_skinny(p, lds, lane, wave, G, bid);
    }
    SEAM(1);
    if (IN(2)) { phase2(p, lds, tid, lane, wave, G, bid); }
    SEAM(2);
    if (IN(3)) { phase3_scan(p, lds, lane, wave, bid); }
    SEAM(3);
    if (IN(4)) { phase4_onorm(p, tid, G, bid); phase3_sample(p, lds, tid, lane, wave, G, bid); }
    SEAM(4);
    if (IN(5)) {
        pg8::Gemm g{(const bf16_t*)(p.ws + WS_A2), (const bf16_t*)(p.ws + WS_W2T), NP, 1024, 1024}; pg8::StaticOrder S; S.init(NP, 1024, G, bid);
        Epi<4> E{(bf16_t*)(p.ws + WS_H1B), nullptr, nullptr, p.in[0], (float*)(p.ws + WS_SS2), nullptr, nullptr};
        pg8::gemm_phase<Epi<4>, pg8::StaticOrder, true, true>(ring, g, S, E);
        phase4_skinny(p, lds, lane, wave, G, bid);
    }
    SEAM(5);
    if (IN(6)) {
        pg8::Gemm g{(const bf16_t*)(p.ws + WS_H1B), (const bf16_t*)(p.ws + WS_W3T), NP, 2560, 1024}; pg8::StaticOrder S; S.init(NP, 2560, G, bid);
        Epi<5> E{(bf16_t*)(p.ws + WS_KVQG), nullptr, nullptr, nullptr, (float*)(p.ws + WS_SS2), nullptr, nullptr};
        pg8::gemm_phase<Epi<5>, pg8::StaticOrder, true, true>(ring, g, S, E);
        phase5_skinny(p, lds, lane, wave, G, bid);
    }
    SEAM(6);
    if (IN(7)) { phase6(p, lds, tid, lane, wave, G, bid); }
    SEAM(7);
    if (IN(8)) {
        pg8::Gemm g{(const bf16_t*)(p.ws + WS_A3), (const bf16_t*)(p.ws + WS_W4T), NP, 1024, 1024}; pg8::StaticOrder S; S.init(NP, 1024, G, bid);
        Epi<7> E{nullptr, nullptr, p.out + O_YP, nullptr, nullptr, nullptr, (const bf16_t*)(p.ws + WS_H1B)};
        pg8::gemm_phase<Epi<7>, pg8::StaticOrder, true, true>(ring, g, S, E);
        phase7_skinny(p, lds, lane, wave, G, bid);
    }
#undef IN
#undef SEAM
}

extern "C" void kernel_launch(void* const* d_in, const int* in_sizes, int n_in, void* d_out, int out_size, void* d_ws, size_t ws_size, hipStream_t stream) {
    static int grid = 0;
    if (grid == 0) {
        if (n_in != 21 || ws_size < WS_END) { fprintf(stderr, "kernel_launch: unexpected n_in %d / ws %zu\n", n_in, ws_size); grid = -1; return; }
        int dev = 0, cus = 0, per_cu = 0;
        if (hipGetDevice(&dev) != hipSuccess || hipDeviceGetAttribute(&cus, hipDeviceAttributeMultiprocessorCount, dev) != hipSuccess) { grid = -1; return; }
        if (hipFuncSetAttribute((const void*)yoco_fwd, hipFuncAttributeMaxDynamicSharedMemorySize, LDS_BYTES) != hipSuccess) { fprintf(stderr, "kernel_launch: hipFuncSetAttribute failed\n"); grid = -1; return; }
        if (hipOccupancyMaxActiveBlocksPerMultiprocessor(&per_cu, (const void*)yoco_fwd, 512, LDS_BYTES) != hipSuccess || per_cu < 1) { fprintf(stderr, "kernel_launch: occupancy query says %d\n", per_cu); }
        (void)hipGetLastError();
        grid = cus;
        if (grid != 256) fprintf(stderr, "kernel_launch: note: %d CUs\n", grid);
    }
    if (grid < 0) return;
    (void)hipMemsetAsync((char*)d_ws + WS_CTL, 0, 16384, stream);
    Params p{};
    for (int i = 0; i < 21; ++i) p.in[i] = (const float*)d_in[i];
    p.out = (float*)d_out; p.ws = (unsigned char*)d_ws;
#if MK_N_LAUNCHES == 1
    p.ph_lo = 0; p.ph_hi = 9 | ((MK_DOUBLE + 1) << 8);
    void* args[] = {&p};
    hipError_t e = hipLaunchCooperativeKernel((const void*)yoco_fwd, dim3(grid), dim3(512), args, LDS_BYTES, stream);
    if (e != hipSuccess) fprintf(stderr, "cooperative launch failed: %s (grid %d)\n", hipGetErrorString(e), grid);
#else
    for (int k = 0; k < MK_STOP; ++k) { p.ph_lo = k; p.ph_hi = k + 1; hipLaunchKernelGGL(yoco_fwd, dim3(grid), dim3(512), LDS_BYTES, stream, p); }
    if (MK_STOP < 9) (void)hipMemsetAsync(d_out, 0, (size_t)16777216 * 4, stream);
#endif
}
```

```cpp
#include <hip/hip_runtime.h>
#include <hip/hip_cooperative_groups.h>
#include <cstdio>
#include <cstdint>
namespace cg = cooperative_groups;
#ifndef MK_N_LAUNCHES
#define MK_N_LAUNCHES 1
#define MK_STOP 9
#ifndef MK_DOUBLE
#define MK_DOUBLE -1
#endif
#endif
namespace pg8 {
#define PG8_LAS __attribute__((address_space(3)))
typedef unsigned short bf16_t;
typedef short bf16x8 __attribute__((ext_vector_type(8)));
typedef float f32x4 __attribute__((ext_vector_type(4)));
typedef unsigned u32x4 __attribute__((ext_vector_type(4)));
constexpr int BM = 256, BK = 64, HALF = 128, HTB = HALF * BK * 2  , STAGE_BYTES = 8 * HTB, NXCD = 8, WGM = 8;

__host__ __device__ __forceinline__ int lds_byte(int r, int c) { const int st = (r >> 4) * 2 + (c >> 5), rr = r & 15, cc = c & 31, ob = rr * 64 + cc * 2; return st * 1024 + (ob ^ (((ob >> 9) & 1) << 5)); }
__host__ __device__ __forceinline__ void stage_rc(int b, int& R, int& C) { const int st = b / 1024, sb = b % 1024, swz = sb ^ (((sb >> 9) & 1) << 5); R = (st >> 1) * 16 + swz / 64; C = (st & 1) * 32 + (swz % 64) / 2; }
__host__ __device__ __forceinline__ int perm32(int rho) { const int n = rho >> 4, i = rho & 15; return 8 * (i >> 2) + 4 * n + (i & 3); }

struct Unit { int pm, pn; };
struct Gemm { const bf16_t* A; const bf16_t* Bt; int M, N, K; };

struct StaticOrder {
    int nM, nN, nwg, G, c;
    __host__ __device__ void init(int M, int N, int G_, int c_) { nM = M / BM; nN = N / BM; nwg = nM * nN; G = G_; c = c_; }
    __host__ __device__ bool next(int i, Unit& u) const {
        const long L = (long)i * G + c; if (L >= nwg) return false;
        int wgid = (int)L; { const int q = nwg / NXCD, r = nwg % NXCD, xcd = wgid % NXCD, off = wgid / NXCD; wgid = (xcd < r ? xcd * (q + 1) : r * (q + 1) + (xcd - r) * q) + off; }
        const int nig = WGM * nN, gid = wgid / nig, fm = gid * WGM, gsz = (nM - fm) < WGM ? (nM - fm) : WGM;
        u.pm = fm + ((wgid % nig) % gsz); u.pn = (wgid % nig) / gsz; return true;
    }
    __device__ __forceinline__ void a_ready(const Unit&) const {}
    __device__ __forceinline__ void done(const Unit&) const {}
};

__device__ __forceinline__ unsigned cvt_pk_bf16(float lo, float hi) { unsigned r; asm volatile("v_cvt_pk_bf16_f32 %0, %1, %2" : "=v"(r) : "v"(lo), "v"(hi)); return r; }
template <class Epi, class Sched, bool ALIGN_EPI = false, bool SP2 = false>
__device__ __forceinline__ void gemm_phase(PG8_LAS unsigned char* lds, const Gemm g, const Sched& S, const Epi& E) {
    const int tid = threadIdx.x, wid = __builtin_amdgcn_readfirstlane(tid >> 6), lane = tid & 63, wr = wid >> 2, wc = wid & 3, fr = lane & 15, fq = lane >> 4;
    const int K = g.K, nt = K / BK;
    unsigned voffA[2], voffB[2];
#pragma unroll
    for (int i = 0; i < 2; ++i) { int R, C; stage_rc(tid * 16 + i * 8192, R, C); const int Rb = Epi::PERM ? ((R & ~31) + perm32(R & 31)) : R;
        voffA[i] = (unsigned)(R * K + C) * 2u; voffB[i] = (unsigned)(Rb * K + C) * 2u; }
    const size_t kstep = (size_t)(BK * 2);
    const size_t hstep = (size_t)HALF * K * 2;
    const size_t tstep = 2 * hstep;
    const unsigned ldsw = (unsigned)wid * 1024u;
    const int aoff = lds_byte(wr * 64 + fr, fq * 8), boff = lds_byte(wc * 32 + fr, fq * 8);
#define PG8_SA(b, h) (((b) * 2 + (h)) * HTB)
#define PG8_SB(b, h) ((4 + (b) * 2 + (h)) * HTB)
#define PG8_STAGE(bufoff, gbase, voff) do { _Pragma("unroll") for (int _i = 0; _i < 2; ++_i) \
        __builtin_amdgcn_global_load_lds((const unsigned*)((const char*)(gbase) + (voff)[_i]), (PG8_LAS unsigned*)(lds + (bufoff) + ldsw + _i * 8192), 16, 0, 0); } while (0)
#define PG8_LDA(dst, b, h) do { _Pragma("unroll") for (int m = 0; m < 4; ++m) _Pragma("unroll") for (int k = 0; k < 2; ++k) dst[m][k] = *(const PG8_LAS bf16x8*)(lds + PG8_SA(b, h) + aoff + m * 2048 + k * 1024); } while (0)
#define PG8_LDB(dst, b, h) do { _Pragma("unroll") for (int n = 0; n < 2; ++n) _Pragma("unroll") for (int k = 0; k < 2; ++k) dst[n][k] = *(const PG8_LAS bf16x8*)(lds + PG8_SB(b, h) + boff + n * 2048 + k * 1024); } while (0)
#define PG8_MMA(ai, bj, At, Bt) do { __builtin_amdgcn_s_setprio(1); _Pragma("unroll") for (int m = 0; m < 4; ++m) _Pragma("unroll") for (int n = 0; n < 2; ++n) _Pragma("unroll") for (int k = 0; k < 2; ++k) \
        acc[ai][bj][m][n] = __builtin_amdgcn_mfma_f32_16x16x32_bf16(Bt[n][k], At[m][k], acc[ai][bj][m][n], 0, 0, 0); __builtin_amdgcn_s_setprio(0); } while (0)
#define PG8_WAIT_V(n) asm volatile("s_waitcnt vmcnt(" #n ")" ::: "memory")
#define PG8_WAIT_L(n) asm volatile("s_waitcnt lgkmcnt(" #n ")" ::: "memory")
#define PG8_BAR __builtin_amdgcn_s_barrier()
#define PG8_SCHED __builtin_amdgcn_sched_barrier(0)
    Unit cur, nxt; int ui = 0;
    if (!S.next(0, cur)) return;
    f32x4 acc[2][2][4][2];
#pragma unroll
    for (int a = 0; a < 2; ++a)
#pragma unroll
        for (int b = 0; b < 2; ++b)
#pragma unroll
            for (int m = 0; m < 4; ++m)
#pragma unroll
                for (int n = 0; n < 2; ++n) acc[a][b][m][n] = (f32x4){0.f, 0.f, 0.f, 0.f};
    bf16x8 At[4][2], B0[2][2], B1[2][2];
    const char* cA = (const char*)g.A + (size_t)cur.pm * tstep; const char* cB = (const char*)g.Bt + (size_t)cur.pn * tstep;
    S.a_ready(cur);
    if constexpr (SP2) {
        PG8_STAGE(PG8_SB(0, 0), cB, voffB); PG8_STAGE(PG8_SB(0, 1), cB + hstep, voffB); PG8_STAGE(PG8_SA(0, 0), cA, voffA); PG8_STAGE(PG8_SA(0, 1), cA + hstep, voffA);
        if (wr == 1) PG8_BAR;
        PG8_WAIT_V(2); PG8_BAR;
        PG8_STAGE(PG8_SB(1, 0), cB + kstep, voffB); PG8_STAGE(PG8_SA(1, 0), cA + kstep, voffA); PG8_STAGE(PG8_SB(1, 1), cB + hstep + kstep, voffB);
        PG8_WAIT_V(6); PG8_BAR;
    } else {
        PG8_STAGE(PG8_SB(0, 0), cB, voffB); PG8_STAGE(PG8_SA(0, 0), cA, voffA); PG8_STAGE(PG8_SB(0, 1), cB + hstep, voffB); PG8_STAGE(PG8_SA(0, 1), cA + hstep, voffA);
        if (wr == 1) PG8_BAR;
        PG8_WAIT_V(4); PG8_BAR;
        PG8_STAGE(PG8_SB(1, 0), cB + kstep, voffB); PG8_STAGE(PG8_SA(1, 0), cA + kstep, voffA); PG8_STAGE(PG8_SB(1, 1), cB + hstep + kstep, voffB);
        PG8_WAIT_V(6); PG8_BAR;
    }
    for (;;) {
        const bool has_next = S.next(ui + 1, nxt);
        const char* nA = has_next ? (const char*)g.A + (size_t)nxt.pm * tstep : cA; const char* nB = has_next ? (const char*)g.Bt + (size_t)nxt.pn * tstep : cB;
        for (int t = 0; t < nt; t += 2) {
            const bool last = (t == nt - 2);
            const char* a1 = cA + (size_t)(t + 1) * kstep;
            const char* a2 = last ? nA : cA + (size_t)(t + 2) * kstep; const char* b2 = last ? nB : cB + (size_t)(t + 2) * kstep;
            const char* a3 = a2 + kstep; const char* b3 = b2 + kstep;
            if (last && has_next) S.a_ready(nxt);
            if constexpr (SP2) {
            PG8_LDB(B0, 0, 0); PG8_LDB(B1, 0, 1); PG8_SCHED; PG8_LDA(At, 0, 0); PG8_STAGE(PG8_SA(1, 1), a1 + hstep, voffA);
            PG8_WAIT_V(8); PG8_WAIT_L(0); PG8_BAR; PG8_MMA(0, 0, At, B0); PG8_MMA(0, 1, At, B1); PG8_BAR; PG8_SCHED;
            PG8_LDA(At, 0, 1); PG8_STAGE(PG8_SB(0, 0), b2, voffB); PG8_STAGE(PG8_SB(0, 1), b2 + hstep, voffB); PG8_STAGE(PG8_SA(0, 0), a2, voffA);
            PG8_WAIT_V(8); PG8_WAIT_L(0); PG8_BAR; PG8_MMA(1, 0, At, B0); PG8_MMA(1, 1, At, B1); PG8_BAR; PG8_SCHED;
            PG8_LDB(B0, 1, 0); PG8_LDB(B1, 1, 1); PG8_SCHED; PG8_LDA(At, 1, 0); PG8_STAGE(PG8_SA(0, 1), a2 + hstep, voffA);
            PG8_WAIT_V(8); PG8_WAIT_L(0); PG8_BAR; PG8_MMA(0, 0, At, B0); PG8_MMA(0, 1, At, B1); PG8_BAR; PG8_SCHED;
            PG8_LDA(At, 1, 1); PG8_STAGE(PG8_SB(1, 0), b3, voffB); PG8_STAGE(PG8_SB(1, 1), b3 + hstep, voffB); PG8_STAGE(PG8_SA(1, 0), a3, voffA);
            PG8_WAIT_V(8); PG8_WAIT_L(0); PG8_BAR; PG8_MMA(1, 0, At, B0); PG8_MMA(1, 1, At, B1); PG8_BAR; PG8_SCHED;
            } else {
            PG8_LDB(B0, 0, 0); PG8_SCHED; PG8_LDA(At, 0, 0); PG8_STAGE(PG8_SA(1, 1), a1 + hstep, voffA);
            PG8_WAIT_L(8); PG8_BAR; PG8_WAIT_L(0); PG8_MMA(0, 0, At, B0); PG8_BAR; PG8_SCHED;
            PG8_LDB(B1, 0, 1); PG8_STAGE(PG8_SB(0, 0), b2, voffB);
            PG8_BAR; PG8_WAIT_L(0); PG8_MMA(0, 1, At, B1); PG8_BAR;
            PG8_LDA(At, 0, 1); PG8_STAGE(PG8_SA(0, 0), a2, voffA);
            PG8_BAR; PG8_WAIT_L(0); PG8_MMA(1, 0, At, B0); PG8_BAR; PG8_SCHED;
            PG8_STAGE(PG8_SB(0, 1), b2 + hstep, voffB);
            PG8_WAIT_V(6); PG8_BAR; PG8_MMA(1, 1, At, B1); PG8_BAR;
            PG8_LDB(B0, 1, 0); PG8_SCHED; PG8_LDA(At, 1, 0); PG8_STAGE(PG8_SA(0, 1), a2 + hstep, voffA);
            PG8_WAIT_L(8); PG8_BAR; PG8_WAIT_L(0); PG8_MMA(0, 0, At, B0); PG8_BAR; PG8_SCHED;
            PG8_LDB(B1, 1, 1); PG8_STAGE(PG8_SB(1, 0), b3, voffB);
            PG8_BAR; PG8_WAIT_L(0); PG8_MMA(0, 1, At, B1); PG8_BAR;
            PG8_LDA(At, 1, 1); PG8_STAGE(PG8_SA(1, 0), a3, voffA);
            PG8_BAR; PG8_WAIT_L(0); PG8_MMA(1, 0, At, B0); PG8_BAR; PG8_SCHED;
            PG8_STAGE(PG8_SB(1, 1), b3 + hstep, voffB);
            PG8_WAIT_V(6); PG8_BAR; PG8_MMA(1, 1, At, B1); PG8_BAR;
            }
        }
        if constexpr (ALIGN_EPI) { if (wr == 0) PG8_BAR; }
        if constexpr (!Epi::AFTER_DRAIN) { E(acc, cur, wr, wc, fr, fq); S.done(cur); }
        if (!has_next) break;
#pragma unroll
        for (int a = 0; a < 2; ++a)
#pragma unroll
            for (int b = 0; b < 2; ++b)
#pragma unroll
                for (int m = 0; m < 4; ++m)
#pragma unroll
                    for (int n = 0; n < 2; ++n) acc[a][b][m][n] = (f32x4){0.f, 0.f, 0.f, 0.f};
        cur = nxt; cA = nA; cB = nB; ++ui;
        if constexpr (ALIGN_EPI) { if (wr == 1) PG8_BAR; }
    }
    PG8_WAIT_V(0);
    if constexpr (!ALIGN_EPI) { if (wr == 0) PG8_BAR; }
    PG8_BAR;
    if constexpr (Epi::AFTER_DRAIN) { E.fused(acc, cur, wr, wc, fr, fq, lds, wid, lane); S.done(cur); }
#undef PG8_SA
#undef PG8_SB
#undef PG8_STAGE
#undef PG8_LDA
#undef PG8_LDB
#undef PG8_MMA
#undef PG8_WAIT_V
#undef PG8_WAIT_L
#undef PG8_BAR
#undef PG8_SCHED
}
}

using pg8::bf16_t; using pg8::bf16x8; using pg8::f32x4; using pg8::u32x4;
typedef short s16x4 __attribute__((ext_vector_type(4)));
typedef short v4i16_t __attribute__((ext_vector_type(4)));
typedef unsigned u32x2 __attribute__((ext_vector_type(2)));
#define LAS __attribute__((address_space(3)))
#define DEV __device__ __forceinline__

constexpr int NP = 16384, NS = 128, NR = NP + NS;
constexpr float EPS = 1e-6f;
constexpr size_t O_YP = 0, O_YS = 16777216, O_CONVP = 16908288, O_SSMP = 16945152, O_KWP = 17469440, O_VWP = 17600512,
                 O_CONVS = 17731584, O_SSMS = 18911232, O_KWS = 35688448, O_VWS = 39882752;
constexpr size_t MiB = 1u << 20;
constexpr size_t WS_CTL = 0, CTL_BYTES = 1 * MiB;
constexpr size_t WS_SS2 = 64 * 1024, WS_GT = 256 * 1024, WS_RS1 = 512 * 1024;
constexpr size_t WS_W1T = 1 * MiB, WS_W2T = 10 * MiB, WS_W3T = 12 * MiB, WS_W4T = 17 * MiB, WS_AB = 19 * MiB;
constexpr size_t WS_XB = 21 * MiB, WS_QK = 21 * MiB, WS_H1B = 21 * MiB;
constexpr size_t WS_QKV = 55 * MiB, WS_A2 = 55 * MiB, WS_A3 = 55 * MiB;
constexpr size_t WS_H1 = 88 * MiB, WS_ORAW = 88 * MiB;
constexpr size_t WS_GATE = 152 * MiB, WS_KVQG = 153 * MiB;
constexpr size_t WS_KDT = 185 * MiB, WS_UT = 217 * MiB;
constexpr size_t WS_END = 249 * MiB;
constexpr int LDS_BYTES = 152 * 1024;

struct Params { const float* in[21]; float* out; unsigned char* ws; int ph_lo, ph_hi; };

DEV float bf2f(unsigned short b) { return __uint_as_float((unsigned)b << 16); }
DEV float bf2f(short b) { return __uint_as_float(((unsigned)(unsigned short)b) << 16); }
typedef __bf16 bf16x2_t __attribute__((ext_vector_type(2)));
typedef float f32x2_t __attribute__((ext_vector_type(2)));
DEV unsigned cvt_pk(float lo, float hi) { f32x2_t v = {lo, hi}; return __builtin_bit_cast(unsigned, __builtin_convertvector(v, bf16x2_t)); }
DEV float sigm(float x) { return __builtin_amdgcn_rcpf(1.f + __expf(-x)); }
DEV float silu(float x) { return x * __builtin_amdgcn_rcpf(1.f + __expf(-x)); }
DEV f32x4 mfma16(bf16x8 a, bf16x8 b, f32x4 c) { return __builtin_amdgcn_mfma_f32_16x16x32_bf16(a, b, c, 0, 0, 0); }
DEV float wave_sum(float v) {
#pragma unroll
    for (int o = 1; o < 64; o <<= 1) v += __shfl_xor(v, o);
    return v;
}
DEV float wave_max(float v) {
#pragma unroll
    for (int o = 1; o < 64; o <<= 1) v = fmaxf(v, __shfl_xor(v, o));
    return v;
}
DEV bf16x8 pack8(const float* v) { u32x4 w; w.x = cvt_pk(v[0], v[1]); w.y = cvt_pk(v[2], v[3]); w.z = cvt_pk(v[4], v[5]); w.w = cvt_pk(v[6], v[7]); return __builtin_bit_cast(bf16x8, w); }
DEV bf16x8 pack44(f32x4 a, f32x4 b) { u32x4 w; w.x = cvt_pk(a[0], a[1]); w.y = cvt_pk(a[2], a[3]); w.z = cvt_pk(b[0], b[1]); w.w = cvt_pk(b[2], b[3]); return __builtin_bit_cast(bf16x8, w); }
DEV u32x2 pack4(f32x4 a) { u32x2 w; w.x = cvt_pk(a[0], a[1]); w.y = cvt_pk(a[2], a[3]); return w; }
DEV s16x4 ldstr(const LAS bf16_t* X, int stride, int row0, int col0, int fr) {
    const LAS bf16_t* p = X + (row0 + (fr >> 2)) * stride + col0 + 4 * (fr & 3);
    return __builtin_bit_cast(s16x4, __builtin_amdgcn_ds_read_tr16_b64_v4i16((LAS v4i16_t*)p));
}
DEV bf16x8 cat4(s16x4 a, s16x4 b) { bf16x8 r; r[0] = a[0]; r[1] = a[1]; r[2] = a[2]; r[3] = a[3]; r[4] = b[0]; r[5] = b[1]; r[6] = b[2]; r[7] = b[3]; return r; }
#define BLOCK_BAR() __syncthreads()

template <int MODE> struct Epi {
    static constexpr bool PERM = true, AFTER_DRAIN = false;
    bf16_t* ob; bf16_t* ob2; float* of32; const float* res; float* ss; const float* rs; const bf16_t* resb;
    __device__ __forceinline__ void operator()(const f32x4 (&acc)[2][2][4][2], const pg8::Unit& u, int wr, int wc, int fr, int fq) const {
        const int row0 = u.pm * 256 + wr * 64 + fr, colt = u.pn * 256 + wc * 32 + 8 * fq;
        float scv[2][4];
        if constexpr (MODE == 1 || MODE == 5) {
#pragma unroll
            for (int ai = 0; ai < 2; ++ai)
#pragma unroll
                for (int m = 0; m < 4; ++m) { const int row = row0 + ai * 128 + m * 16; scv[ai][m] = (MODE == 1) ? rs[row] : ss[row]; }
        }
#pragma unroll
        for (int ai = 0; ai < 2; ++ai)
#pragma unroll
            for (int m = 0; m < 4; ++m) {
                const int row = row0 + ai * 128 + m * 16;
                if constexpr (MODE == 1 || MODE == 5) {
                    float sc;
                    if constexpr (MODE == 1) sc = scv[ai][m]; else sc = rsqrtf(scv[ai][m] * (1.f / 1024.f) + EPS);
#pragma unroll
                    for (int bj = 0; bj < 2; ++bj) {
                        const int col = colt + bj * 128;
                        const bf16x8 w = pack44(acc[ai][bj][m][0] * sc, acc[ai][bj][m][1] * sc);
                        if constexpr (MODE == 1) {
                            if (col < 3072) *(bf16x8*)(ob + (size_t)row * 3072 + col) = w; else *(bf16x8*)(ob2 + (size_t)row * 1024 + (col - 3072)) = w;
                        } else *(bf16x8*)(ob + (size_t)row * 2560 + col) = w;
                    }
                } else {
                    float sq = 0.f;
#pragma unroll
                    for (int bj = 0; bj < 2; ++bj) {
                        const size_t off = (size_t)row * 1024 + colt + bj * 128;
                        f32x4 h0, h1;
                        if constexpr (MODE == 4) { h0 = *(const f32x4*)(res + off) + acc[ai][bj][m][0]; h1 = *(const f32x4*)(res + off + 4) + acc[ai][bj][m][1]; }
                        else { const bf16x8 rb = *(const bf16x8*)(resb + off);
#pragma unroll
                            for (int j = 0; j < 4; ++j) { h0[j] = bf2f(rb[j]) + acc[ai][bj][m][0][j]; h1[j] = bf2f(rb[4 + j]) + acc[ai][bj][m][1][j]; }
                            __builtin_nontemporal_store(h0, (f32x4*)(of32 + off)); __builtin_nontemporal_store(h1, (f32x4*)(of32 + off + 4)); }
                        if constexpr (MODE == 4) {
                            *(bf16x8*)(ob + off) = pack44(h0, h1);
                            sq += (h0[0] * h0[0] + h0[1] * h0[1]) + (h0[2] * h0[2] + h0[3] * h0[3]) + (h1[0] * h1[0] + h1[1] * h1[1]) + (h1[2] * h1[2] + h1[3] * h1[3]);
                        }
                    }
                    if constexpr (MODE == 4) {
                        sq += __shfl_xor(sq, 16); sq += __shfl_xor(sq, 32);
                        if (fq == 0) __hip_atomic_fetch_add(ss + row, sq, __ATOMIC_RELAXED, __HIP_MEMORY_SCOPE_AGENT);
                    }
                }
            }
    }
};

DEV f32x4 skinny_mma(const bf16_t* A, const bf16_t* Bt, int n0, int wave, int fr, int fq, unsigned char* lds) {
    LAS float* red = (LAS float*)lds;
    const int lane = fr + 16 * fq;
    bf16x8 x[4], a[8][4];
#pragma unroll
    for (int ks = 0; ks < 4; ++ks) x[ks] = *(const bf16x8*)(Bt + (size_t)(n0 + fr) * 1024 + 128 * wave + 32 * ks + 8 * fq);
#pragma unroll
    for (int rt = 0; rt < 8; ++rt)
#pragma unroll
        for (int ks = 0; ks < 4; ++ks) a[rt][ks] = *(const bf16x8*)(A + (size_t)(16 * rt + fr) * 1024 + 128 * wave + 32 * ks + 8 * fq);
#pragma unroll
    for (int rt = 0; rt < 8; ++rt) { f32x4 acc = {0.f, 0.f, 0.f, 0.f};
#pragma unroll
        for (int ks = 0; ks < 4; ++ks) acc = mfma16(x[ks], a[rt][ks], acc);
        *(LAS f32x4*)(red + ((rt * 8 + wave) * 64 + lane) * 4) = acc; }
    __syncthreads();
    f32x4 sum = {0.f, 0.f, 0.f, 0.f};
#pragma unroll
    for (int w2 = 0; w2 < 8; ++w2) sum += *(const LAS f32x4*)(red + ((wave * 8 + w2) * 64 + lane) * 4);
    __syncthreads();
    return sum;
}

DEV void transpose_item(const float* W, const float* gain, int K, int N, bf16_t* WT, int row_off, LAS float* scr, int item, int lane) {
    const int nblk = (N + 31) / 32, kb = item / nblk, nb = item % nblk, k0 = 64 * kb, n0 = 32 * nb;
    const int n = n0 + (lane & 31);
    float wv[32];
    const int ncl = n < N ? n : N - 1;
#pragma unroll
    for (int i = 0; i < 32; ++i) wv[i] = W[(size_t)(k0 + 2 * i + (lane >> 5)) * N + ncl];
#pragma unroll
    for (int i = 0; i < 32; ++i) {
        const int kk = 2 * i + (lane >> 5);
        float v = (n < N) ? wv[i] : 0.f;
        if (gain) v *= gain[k0 + kk];
        scr[kk * 33 + (lane & 31)] = v;
    }
    asm volatile("s_waitcnt lgkmcnt(0)" ::: "memory");
    const int c = lane & 7;
#pragma unroll
    for (int j = 0; j < 4; ++j) {
        const int nn = (lane >> 3) + 8 * j; const LAS float* s = scr + (8 * c) * 33 + nn;
        u32x4 o; o.x = cvt_pk(s[0 * 33], s[1 * 33]); o.y = cvt_pk(s[2 * 33], s[3 * 33]); o.z = cvt_pk(s[4 * 33], s[5 * 33]); o.w = cvt_pk(s[6 * 33], s[7 * 33]);
        if (n0 + nn < N) *(u32x4*)(WT + (size_t)(row_off + n0 + nn) * K + k0 + 8 * c) = o;
    }
    asm volatile("s_waitcnt lgkmcnt(0)" ::: "memory");
}

DEV void phase0(const Params& p, unsigned char* lds, int lane, int wave, int G, int bid) {
    LAS float* scr = (LAS float*)lds + wave * 2176;
    const int gw = bid * 8 + wave, NGW = G * 8;
    bf16_t* W1T = (bf16_t*)(p.ws + WS_W1T); bf16_t* W2T = (bf16_t*)(p.ws + WS_W2T); bf16_t* W3T = (bf16_t*)(p.ws + WS_W3T); bf16_t* W4T = (bf16_t*)(p.ws + WS_W4T);
    constexpr int I1 = 16 * 129, I2 = 16 * 32, I3A = 16 * 16, I3B = 16 * 64, I4 = 16 * 32, NITEMS = I1 + I2 + I3A + I3B + I4;
    for (int it = gw; it < NITEMS; it += NGW) {
        int r = it;
        if (r < I1) { transpose_item(p.in[7], p.in[6], 1024, 4112, W1T, 0, scr, r, lane); continue; } r -= I1;
        if (r < I2) { transpose_item(p.in[12], nullptr, 1024, 1024, W2T, 0, scr, r, lane); continue; } r -= I2;
        if (r < I3A) { transpose_item(p.in[14], p.in[13], 1024, 512, W3T, 0, scr, r, lane); continue; } r -= I3A;
        if (r < I3B) { transpose_item(p.in[17], p.in[16], 1024, 2048, W3T, 512, scr, r, lane); continue; } r -= I3B;
        transpose_item(p.in[20], nullptr, 1024, 1024, W4T, 0, scr, r, lane);
    }
    bf16_t* XB = (bf16_t*)(p.ws + WS_XB); float* RS1 = (float*)(p.ws + WS_RS1); float* AB = (float*)(p.ws + WS_AB);
    { float* SS2 = (float*)(p.ws + WS_SS2); for (int i = gw * 64 + lane; i < NR; i += NGW * 64) SS2[i] = 0.f; }
    LAS float* wab = (LAS float*)((LAS unsigned char*)lds + 73728);
    {
        float wv[32], gv[32];
#pragma unroll
        for (int q = 0; q < 32; ++q) { const int i = threadIdx.x + 512 * q, k = i >> 4, c = i & 15; wv[q] = p.in[7][(size_t)k * 4112 + 4096 + c]; gv[q] = p.in[6][k]; }
#pragma unroll
        for (int q = 0; q < 32; ++q) { const int i = threadIdx.x + 512 * q, k = i >> 4, c = i & 15;
            wab[((((k >> 8) * 4 + (k & 3)) * 4 + (c >> 2)) * 64 + ((k >> 2) & 63)) * 4 + (c & 3)] = wv[q] * gv[q]; }
    }
    __syncthreads();
#pragma unroll 1
    for (int m0 = 4 * gw; m0 < NR; m0 += 4 * NGW) {
        f32x4 v[4][4]; float rs[4];
#pragma unroll
        for (int r = 0; r < 4; ++r) {
            const int m = m0 + r;
            const float* xrow = (m < NP) ? p.in[0] + (size_t)m * 1024 : p.in[1] + (size_t)(m - NP) * 1024;
            const f32x4* xr = (const f32x4*)xrow + lane; float s = 0.f;
#pragma unroll
            for (int j = 0; j < 4; ++j) { v[r][j] = __builtin_nontemporal_load(xr + 64 * j); s += (v[r][j][0] * v[r][j][0] + v[r][j][1] * v[r][j][1]) + (v[r][j][2] * v[r][j][2] + v[r][j][3] * v[r][j][3]); }
            rs[r] = rsqrtf(wave_sum(s) * (1.f / 1024.f) + EPS);
            if (lane == 0) RS1[m] = rs[r];
            u32x2* o8 = (u32x2*)(XB + (size_t)m * 1024) + lane;
#pragma unroll
            for (int j = 0; j < 4; ++j) o8[64 * j] = pack4(v[r][j]);
        }
        float acc[64];
#pragma unroll
        for (int i = 0; i < 64; ++i) acc[i] = 0.f;
#pragma unroll
        for (int j = 0; j < 4; ++j)
#pragma unroll
            for (int e = 0; e < 4; ++e)
#pragma unroll
                for (int c4 = 0; c4 < 4; ++c4) { const f32x4 w = *(const LAS f32x4*)(wab + (((j * 4 + e) * 4 + c4) * 64 + lane) * 4);
#pragma unroll
                    for (int r = 0; r < 4; ++r)
#pragma unroll
                        for (int ci = 0; ci < 4; ++ci) acc[r * 16 + c4 * 4 + ci] += v[r][j][e] * w[ci];
                    if (c4 == 3) __builtin_amdgcn_sched_barrier(0); }
#pragma unroll
        for (int half = 32; half >= 1; half >>= 1) { const bool up = (lane & half) != 0;
#pragma unroll
            for (int i = 0; i < half; ++i) { const float snd = up ? acc[i] : acc[i + half], kp = up ? acc[i + half] : acc[i]; acc[i] = kp + __shfl_xor(snd, half); } }
        const int rr = lane >> 4; const float rsel = rr == 0 ? rs[0] : (rr == 1 ? rs[1] : (rr == 2 ? rs[2] : rs[3]));
        AB[(size_t)m0 * 16 + lane] = acc[0] * rsel;
    }
}

DEV void phase1_skinny(const Params& p, unsigned char* lds, int lane, int wave, int G, int bid) {
    const int fr = lane & 15, fq = lane >> 4;
    const bf16_t* XB = (const bf16_t*)(p.ws + WS_XB); const bf16_t* W1T = (const bf16_t*)(p.ws + WS_W1T); const float* RS1 = (const float*)(p.ws + WS_RS1);
    bf16_t* QKV = (bf16_t*)(p.ws + WS_QKV); bf16_t* GATE = (bf16_t*)(p.ws + WS_GATE);
    for (int u = bid; u < 256; u += G) {
        const int n0 = 16 * u; const int row = NP + 16 * wave + fr; const float rsv = RS1[row];
        const f32x4 acc = skinny_mma(XB + (size_t)NP * 1024, W1T, n0, wave, fr, fq, lds);
        const int col = n0 + 4 * fq; const u32x2 w = pack4(acc * rsv);
        if (col < 3072) *(u32x2*)(QKV + (size_t)row * 3072 + col) = w; else *(u32x2*)(GATE + (size_t)row * 1024 + (col - 3072)) = w;
    }
}

DEV void conv_frag(const bf16x8 (&x)[4], const LAS bf16_t* wl, int t, float (&out)[8]) {
    float a8[8];
#pragma unroll
    for (int j = 0; j < 8; ++j) a8[j] = 0.f;
#pragma unroll
    for (int i = 0; i < 4; ++i) {
        const float ok = (t - 3 + i) >= 0 ? 1.f : 0.f;
        const bf16x8 w = *(const LAS bf16x8*)(wl + i * 384);
#pragma unroll
        for (int j = 0; j < 8; ++j) a8[j] += (bf2f(w[j]) * ok) * bf2f(x[i][j]);
    }
#pragma unroll
    for (int j = 0; j < 8; ++j) out[j] = silu(a8[j]);
}
DEV void conv_load(const bf16_t* QKV, int b, int t, int cb, bf16x8 (&x)[4]) {
#pragma unroll
    for (int i = 0; i < 4; ++i) { const int tt = t - 3 + i; x[i] = *(const bf16x8*)(QKV + ((size_t)b * 4096 + (tt > 0 ? tt : 0)) * 3072 + cb); }
}
constexpr int P2_HALF = 73728;
DEV void phase2(const Params& p, unsigned char* lds, int tid, int lane, int wave, int G, int bid) {
    const int hb = wave >> 2, w4 = wave & 3;
    LAS unsigned char* L = (LAS unsigned char*)lds + hb * P2_HALF;
    LAS bf16_t* KT = (LAS bf16_t*)L;
    LAS bf16_t* VT = (LAS bf16_t*)(L + 18432);
    LAS float* Ms = (LAS float*)(L + 36864);
    LAS bf16_t* TW = (LAS bf16_t*)(L + 54272);
    LAS bf16_t* TU = (LAS bf16_t*)(L + 63488);
    LAS float* GB = (LAS float*)(L + 72704);
    const float* conv_w = p.in[8]; const float* a_log = p.in[9]; const float* dt_bias = p.in[10];
    const bf16_t* QKV = (const bf16_t*)(p.ws + WS_QKV); const float* AB = (const float*)(p.ws + WS_AB);
    float* GT = (float*)(p.ws + WS_GT);
    bf16_t* Wg = (bf16_t*)(p.out + O_YP); bf16_t* QDg = (bf16_t*)((unsigned char*)(p.out + O_YP) + 32 * MiB);
    bf16_t* KDTg = (bf16_t*)(p.ws + WS_KDT); bf16_t* UTg = (bf16_t*)(p.ws + WS_UT); bf16_t* QKg = (bf16_t*)(p.ws + WS_QK);
    LAS bf16_t* wl = (LAS bf16_t*)((LAS unsigned char*)lds + 2 * P2_HALF) + hb * 1536;
    { const int h0 = (2 * bid + hb) & 7, t4 = (wave & 3) * 64 + lane;
        for (int i = t4; i < 1536; i += 256) { const int tap = i / 384, c = i % 384; wl[i] = (bf16_t)(cvt_pk(conv_w[tap * 3072 + (c >> 7) * 1024 + h0 * 128 + (c & 127)], 0.f) & 0xffffu); } }
    const float dtb_h = dt_bias[(2 * bid + hb) & 7], nalog_h = -expf(a_log[(2 * bid + hb) & 7]);
#define P2_GBETA(uu, dst) do { const int u_ = (uu); const size_t r_ = (size_t)(u_ >> 9) * 4096 + ((u_ >> 3) & 63) * 64 + lane; \
        const float a_ = AB[r_ * 16 + (u_ & 7)], bl_ = AB[r_ * 16 + 8 + (u_ & 7)]; \
        const float x_ = a_ + dtb_h; const float sp_ = x_ > 20.f ? x_ : log1pf(expf(x_)); float g_ = nalog_h * sp_; \
        _Pragma("unroll") for (int o_ = 1; o_ < 64; o_ <<= 1) { const float t_ = __shfl_up(g_, o_); if (lane >= o_) g_ += t_; } \
        (dst)[lane] = g_; (dst)[64 + lane] = 1.f / (1.f + expf(-bl_)); if (lane == 63) GT[u_] = expf(g_); } while (0)
    if (w4 == 1) P2_GBETA(2 * bid + hb, GB);
    BLOCK_BAR();
    for (int idx = bid * 512 + tid; idx < 36864; idx += G * 512) { const int b = idx / 9216, r = (idx % 9216) / 3072, c = idx % 3072;
        p.out[O_CONVP + idx] = bf2f(QKV[(size_t)(b * 4096 + 4093 + r) * 3072 + c]); }
    for (int k = 0; 2 * (bid + k * G) < 2048; ++k) {
        int lane_ = lane; asm volatile("" : "+v"(lane_));
        const int fr = lane_ & 15, fq = lane_ >> 4;
        const int u = 2 * (bid + k * G) + hb;
        const int h = u & 7, n = (u >> 3) & 63, b = u >> 9, t0 = n * 64;
        const size_t rowb = (size_t)b * 4096 + t0;
        LAS float* Gs = GB + (k & 1) * 128; LAS float* Bs = Gs + 64;
        const int tl = 16 * w4 + fr, t = t0 + tl;
        const float Gi = Gs[tl], eGi = __expf(Gi), betai = Bs[tl];
        bf16x8 Qf[4]; int pin = 0;
#pragma unroll
        for (int si = 0; si < 2; ++si) {
            const int sel = 1 - si;
            float vals[4][8]; float ss = 0.f;
            bf16x8 xr[4][4];
#pragma unroll
            for (int ks = 0; ks < 4; ++ks) conv_load(QKV, b, t, sel * 1024 + h * 128 + 32 * ks + 8 * fq + pin, xr[ks]);
#pragma unroll
            for (int ks = 0; ks < 4; ++ks) {
                conv_frag(xr[ks], wl + sel * 128 + 32 * ks + 8 * fq, t, vals[ks]);
#pragma unroll
                for (int j = 0; j < 8; ++j) ss += vals[ks][j] * vals[ks][j];
            }
            asm volatile("" : "+v"(pin), "+v"(vals[3][0]));
            ss += __shfl_xor(ss, 16); ss += __shfl_xor(ss, 32);
            float r = rsqrtf(ss + EPS); if (sel == 0) r *= 0.08838834764831845f;
#pragma unroll
            for (int ks = 0; ks < 4; ++ks) {
#pragma unroll
                for (int j = 0; j < 8; ++j) vals[ks][j] *= r;
                const bf16x8 f = pack8(vals[ks]);
                if (sel == 1) { *(LAS bf16x8*)(KT + tl * 144 + 32 * ks + 8 * fq) = f; }
                else {
                    Qf[ks] = f;
                    f32x4 lo, hi;
#pragma unroll
                    for (int j = 0; j < 4; ++j) { lo[j] = vals[ks][j] * eGi; hi[j] = vals[ks][4 + j] * eGi; }
                    bf16_t* qd = QDg + (size_t)u * 8192 + ((w4 * 4 + ks) * 64 + fr + 32 * (fq & 1)) * 8 + 4 * (fq >> 1);
                    *(u32x2*)qd = pack4(lo); *(u32x2*)(qd + 16 * 8) = pack4(hi);
                }
            }
        }
        BLOCK_BAR();
        bf16x8 Kf[4];
#pragma unroll
        for (int ks = 0; ks < 4; ++ks) Kf[ks] = *(const LAS bf16x8*)(KT + tl * 144 + 32 * ks + 8 * fq);
#pragma unroll 1
        for (int jt = 0; jt < 4; ++jt) {
            bf16_t* qkp = QKg + (size_t)u * 4096 + ((w4 * 2 + (jt >> 1)) * 64 + fr + 16 * fq) * 8 + 4 * (jt & 1);
            if (jt <= w4) {
                f32x4 c1 = {0.f, 0.f, 0.f, 0.f}, c2 = c1;
#pragma unroll
                for (int ks = 0; ks < 4; ++ks) { const bf16x8 a = *(const LAS bf16x8*)(KT + (16 * jt + fr) * 144 + 32 * ks + 8 * fq); c1 = mfma16(a, Kf[ks], c1); c2 = mfma16(a, Qf[ks], c2); }
                const f32x4 Gj = *(const LAS f32x4*)(Gs + 16 * jt + 4 * fq);
                f32x4 qv;
#pragma unroll
                for (int r = 0; r < 4; ++r) { const int j = 16 * jt + 4 * fq + r; const float dec = __expf(fminf(Gi - Gj[r], 0.f));
                    Ms[j * 68 + tl] = (tl > j) ? betai * c1[r] * dec : 0.f; qv[r] = (tl >= j) ? c2[r] * dec : 0.f; }
                *(u32x2*)qkp = pack4(qv);
            } else { u32x2 z; z.x = 0u; z.y = 0u; *(u32x2*)qkp = z; }
        }
        BLOCK_BAR();
        if (w4 == 0) {
            LAS float* X = (LAS float*)VT;
            const float su = Bs[lane], sw = su * __expf(Gs[lane]);
#pragma unroll 1
            for (int ib = 0; ib < 4; ++ib) {
                float acc[16];
#pragma unroll
                for (int r = 0; r < 16; ++r) acc[r] = (lane == 16 * ib + r) ? 1.f : 0.f;
#pragma unroll 8
                for (int j = 0; j < 16 * ib; ++j) {
                    const float xj = X[j * 64 + lane];
#pragma unroll
                    for (int q = 0; q < 4; ++q) { const f32x4 mc = *(const LAS f32x4*)(Ms + j * 68 + 16 * ib + 4 * q);
#pragma unroll
                        for (int e = 0; e < 4; ++e) acc[4 * q + e] -= mc[e] * xj; }
                }
#pragma unroll
                for (int r = 0; r < 16; ++r) {
                    const float xr = acc[r]; const int j = 16 * ib + r;
#pragma unroll
                    for (int q = 0; q < 4; ++q) if (4 * q + 3 > r) { const f32x4 mc = *(const LAS f32x4*)(Ms + j * 68 + 16 * ib + 4 * q);
#pragma unroll
                        for (int e = 0; e < 4; ++e) if (4 * q + e > r) acc[4 * q + e] -= mc[e] * xr; }
                }
#pragma unroll
                for (int r = 0; r < 16; ++r) { const float xr = acc[r]; const int j = 16 * ib + r;
                    X[j * 64 + lane] = xr;
                    TW[j * 72 + lane] = (bf16_t)(cvt_pk(xr * sw, 0.f) & 0xffffu); TU[j * 72 + lane] = (bf16_t)(cvt_pk(xr * su, 0.f) & 0xffffu); }
            }
        } else {
            const float Glast = Gs[63];
            if (w4 == 1) { const int un = 2 * (bid + (k + 1) * G) + hb; if (un < 2048) P2_GBETA(un, GB + ((k + 1) & 1) * 128); }
            for (int it = (w4 - 1) * 64 + lane; it < 2048; it += 192) {
                const int d = it & 127, jg = it >> 7;
                const f32x4 Gj = *(const LAS f32x4*)(Gs + 4 * jg);
                f32x4 v;
#pragma unroll
                for (int r = 0; r < 4; ++r) v[r] = bf2f(KT[(4 * jg + r) * 144 + d]) * __expf(Glast - Gj[r]);
                *(u32x2*)(KDTg + (size_t)u * 8192 + (((d >> 4) * 2 + (jg >> 3)) * 64 + (d & 15) + 16 * (jg & 3)) * 8 + 4 * ((jg >> 2) & 1)) = pack4(v);
            }
        }
        BLOCK_BAR();
        { bf16x8 xr[4][4];
#pragma unroll
            for (int ks = 0; ks < 4; ++ks) conv_load(QKV, b, t, 2048 + h * 128 + 32 * ks + 8 * fq + pin, xr[ks]);
#pragma unroll
            for (int ks = 0; ks < 4; ++ks) { float vv[8]; conv_frag(xr[ks], wl + 256 + 32 * ks + 8 * fq, t, vv); *(LAS bf16x8*)(VT + tl * 144 + 32 * ks + 8 * fq) = pack8(vv); } }
        BLOCK_BAR();
        {
            f32x4 aw[2][4], au[4][2];
#pragma unroll
            for (int a = 0; a < 2; ++a)
#pragma unroll
                for (int c = 0; c < 4; ++c) { aw[a][c] = (f32x4){0.f, 0.f, 0.f, 0.f}; au[c][a] = aw[a][c]; }
#pragma unroll
            for (int ks = 0; ks < 2; ++ks) {
                bf16x8 Bw[4], Au[4];
#pragma unroll
                for (int it = 0; it < 4; ++it) { Bw[it] = *(const LAS bf16x8*)(TW + (16 * it + fr) * 72 + 32 * ks + 8 * fq); Au[it] = *(const LAS bf16x8*)(TU + (16 * it + fr) * 72 + 32 * ks + 8 * fq); }
#pragma unroll
                for (int tt = 0; tt < 2; ++tt) {
                    const int ct = 16 * (2 * w4 + tt);
                    const bf16x8 Ak = cat4(ldstr(KT, 144, 32 * ks + 8 * fq, ct, fr), ldstr(KT, 144, 32 * ks + 8 * fq + 4, ct, fr));
                    const bf16x8 Bv = cat4(ldstr(VT, 144, 32 * ks + 8 * fq, ct, fr), ldstr(VT, 144, 32 * ks + 8 * fq + 4, ct, fr));
#pragma unroll
                    for (int it = 0; it < 4; ++it) { aw[tt][it] = mfma16(Ak, Bw[it], aw[tt][it]); au[it][tt] = mfma16(Au[it], Bv, au[it][tt]); }
                }
            }
#pragma unroll
            for (int it = 0; it < 4; ++it) {
                *(bf16x8*)(Wg + (size_t)u * 8192 + ((it * 4 + w4) * 64 + fr + 16 * fq) * 8) = pack44(aw[0][it], aw[1][it]);
#pragma unroll
                for (int tt = 0; tt < 2; ++tt) *(u32x2*)(UTg + (size_t)u * 8192 + (((2 * w4 + tt) * 4 + it) * 64 + fr + 16 * fq) * 4) = pack4(au[it][tt]);
            }
        }
        BLOCK_BAR();
    }
}

struct ScanStage { bf16x8 a1[4]; bf16x8 a2[2]; bf16x8 kd[2]; u32x2 u; float gt; };
DEV void phase3_scan(const Params& p, unsigned char* lds, int lane, int wave, int bid) {
    const int fr = lane & 15, fq = lane >> 4;
    const int xc = bid & 7, yc = bid >> 3, bh = 4 * xc + (yc >> 3), sl = yc & 7, b = bh >> 3, h = bh & 7, e0 = 16 * sl;
    LAS bf16_t* SbL = (LAS bf16_t*)lds;
    LAS bf16_t* VbL = SbL + 4 * 64 * 8;
    const int m = wave & 3, dt = wave; const bool lo = wave < 4;
    const bf16_t* A1g = lo ? (const bf16_t*)(p.out + O_YP) : (const bf16_t*)((const unsigned char*)(p.out + O_YP) + 32 * MiB);
    const bf16_t* KDTg = (const bf16_t*)(p.ws + WS_KDT); const bf16_t* UTg = (const bf16_t*)(p.ws + WS_UT); const bf16_t* QKg = (const bf16_t*)(p.ws + WS_QK);
    const float* GT = (const float*)(p.ws + WS_GT); bf16_t* ORAW = (bf16_t*)(p.ws + WS_ORAW);
    LAS bf16_t* sbw = SbL + ((dt >> 1) * 64 + lane) * 8 + 4 * (dt & 1);
    LAS bf16_t* vbw = VbL + ((m >> 1) * 64 + lane) * 8 + 4 * (m & 1);
    f32x4 S = {0.f, 0.f, 0.f, 0.f};
    { u32x2 z; z.x = 0u; z.y = 0u; *(LAS u32x2*)sbw = z; }
    ScanStage st[4];
#define P3_LOAD(sg, nn) do { const size_t u_ = (size_t)((b * 64 + (nn)) * 8 + h); \
        _Pragma("unroll") for (int ks_ = 0; ks_ < 4; ++ks_) sg.a1[ks_] = *(const bf16x8*)(A1g + u_ * 8192 + ((m * 4 + ks_) * 64 + lane) * 8); \
        _Pragma("unroll") for (int k2_ = 0; k2_ < 2; ++k2_) { sg.a2[k2_] = *(const bf16x8*)(QKg + u_ * 4096 + ((m * 2 + k2_) * 64 + lane) * 8); \
            sg.kd[k2_] = *(const bf16x8*)(KDTg + u_ * 8192 + ((dt * 2 + k2_) * 64 + lane) * 8); } \
        sg.u = *(const u32x2*)(UTg + u_ * 8192 + ((sl * 4 + m) * 64 + lane) * 4); sg.gt = GT[u_]; } while (0)
#define P3_BODY(sg, nn, sn, nnext) do { \
        BLOCK_BAR(); \
        { const int nx_ = (nnext) < 64 ? (nnext) : 63; P3_LOAD(sn, nx_); } \
        f32x4 acc = {0.f, 0.f, 0.f, 0.f}; \
        _Pragma("unroll") for (int ks_ = 0; ks_ < 4; ++ks_) acc = mfma16(sg.a1[ks_], *(const LAS bf16x8*)(SbL + (ks_ * 64 + lane) * 8), acc); \
        if (lo) { f32x4 uv; uv[0] = __uint_as_float(sg.u.x << 16); uv[1] = __uint_as_float(sg.u.x & 0xffff0000u); uv[2] = __uint_as_float(sg.u.y << 16); uv[3] = __uint_as_float(sg.u.y & 0xffff0000u); \
            *(LAS u32x2*)vbw = pack4(uv - acc); } \
        BLOCK_BAR(); \
        const bf16x8 vb0 = *(const LAS bf16x8*)(VbL + lane * 8), vb1 = *(const LAS bf16x8*)(VbL + (64 + lane) * 8); \
        if (!lo) { acc = mfma16(sg.a2[0], vb0, acc); acc = mfma16(sg.a2[1], vb1, acc); ow[(nn) & 7] = pack4(acc); } \
        S = S * sg.gt; S = mfma16(sg.kd[0], vb0, S); S = mfma16(sg.kd[1], vb1, S); \
        *(LAS u32x2*)sbw = pack4(S); } while (0)
    P3_LOAD(st[0], 0); P3_LOAD(st[1], 1); P3_LOAD(st[2], 2);
#pragma unroll 1
    for (int n0 = 0; n0 < 64; n0 += 8) {
        u32x2 ow[8];
#pragma unroll
        for (int q = 0; q < 2; ++q) {
            const int n = n0 + 4 * q;
            P3_BODY(st[0], 4 * q, st[3], n + 3);
            P3_BODY(st[1], 4 * q + 1, st[0], n + 4);
            P3_BODY(st[2], 4 * q + 2, st[1], n + 5);
            P3_BODY(st[3], 4 * q + 3, st[2], n + 6);
        }
        if (!lo) {
#pragma unroll
            for (int q = 0; q < 8; ++q) { bf16_t* op = ORAW + ((size_t)b * 4096 + (n0 + q) * 64 + 16 * m + 4 * fq) * 1024 + h * 128 + e0 + fr;
                op[0] = (bf16_t)(ow[q].x & 0xffffu); op[1024] = (bf16_t)(ow[q].x >> 16); op[2048] = (bf16_t)(ow[q].y & 0xffffu); op[3072] = (bf16_t)(ow[q].y >> 16); }
        }
    }
#undef P3_LOAD
#undef P3_BODY
    float* so = p.out + O_SSMP + (size_t)(b * 8 + h) * 16384;
#pragma unroll
    for (int r = 0; r < 4; ++r) so[(16 * dt + 4 * fq + r) * 128 + e0 + fr] = S[r];
}

DEV void phase4_onorm(const Params& p, int tid, int G, int bid) {
    const bf16_t* ORAW = (const bf16_t*)(p.ws + WS_ORAW); const bf16_t* GATE = (const bf16_t*)(p.ws + WS_GATE); const float* o_norm = p.in[11];
    bf16_t* A2 = (bf16_t*)(p.ws + WS_A2);
    const int part = tid & 15;
    const f32x4 n0 = *(const f32x4*)(o_norm + 8 * part), n1 = *(const f32x4*)(o_norm + 8 * part + 4);
#pragma unroll 1
    for (int it0 = bid * 512 + tid; it0 < NP * 8 * 16; it0 += 8 * G * 512) {
      bf16x8 o8v[8], g8v[8];
#pragma unroll
      for (int q = 0; q < 8; ++q) { const size_t off = (size_t)((it0 + q * G * 512) >> 4) * 128 + 8 * part; o8v[q] = *(const bf16x8*)(ORAW + off); g8v[q] = *(const bf16x8*)(GATE + off); }
#pragma unroll
      for (int q = 0; q < 8; ++q) {
        const size_t off = (size_t)((it0 + q * G * 512) >> 4) * 128 + 8 * part;
        const bf16x8 o8 = o8v[q], g8 = g8v[q];
        float ov[8]; float ss = 0.f;
#pragma unroll
        for (int j = 0; j < 8; ++j) { ov[j] = bf2f(o8[j]); ss += ov[j] * ov[j]; }
        ss += __shfl_xor(ss, 1); ss += __shfl_xor(ss, 2); ss += __shfl_xor(ss, 4); ss += __shfl_xor(ss, 8);
        const float rr = rsqrtf(ss * (1.f / 128.f) + EPS);
#pragma unroll
        for (int j = 0; j < 8; ++j) ov[j] = ov[j] * rr * (j < 4 ? n0[j] : n1[j - 4]) * silu(bf2f(g8[j]));
        *(bf16x8*)(A2 + off) = pack8(ov);
      }
    }
}

DEV void phase3_sample(const Params& p, unsigned char* lds, int tid, int lane, int wave, int G, int bid) {
    const int nb = G, sb = bid;
    LAS float* qs = (LAS float*)lds; LAS float* ksm = qs + 128; LAS float* vs = ksm + 128; LAS float* sc = vs + 128; LAS float* part = sc + 16; LAS float* vnew = part + 4096; LAS float* osm = vnew + 128;
    const float* state_conv = p.in[2]; const float* state_ssm = p.in[3]; const float* conv_w = p.in[8]; const float* a_log = p.in[9]; const float* dt_bias = p.in[10]; const float* o_norm = p.in[11];
    const bf16_t* QKV = (const bf16_t*)(p.ws + WS_QKV); const float* AB = (const float*)(p.ws + WS_AB); const bf16_t* GATE = (const bf16_t*)(p.ws + WS_GATE);
    bf16_t* A2 = (bf16_t*)(p.ws + WS_A2);
    for (int u = sb; u < 1024; u += nb) {
        const int s = u >> 3, h = u & 7; const size_t row = NP + s;
        const int dgrp = tid >> 5, e4 = tid & 31;
        const float* S0 = state_ssm + (size_t)(s * 8 + h) * 16384;
        f32x4 s0[8];
#pragma unroll
        for (int i = 0; i < 8; ++i) s0[i] = __builtin_nontemporal_load((const f32x4*)(S0 + (dgrp * 8 + i) * 128 + 4 * e4));
        const float a = AB[row * 16 + h], bl = AB[row * 16 + 8 + h], dtb = dt_bias[h], alg = a_log[h];
        if (tid < 384) {
            const int sel = tid >> 7, d = tid & 127, c = sel * 1024 + h * 128 + d;
            const float b0 = state_conv[(size_t)(s * 3 + 0) * 3072 + c], b1 = state_conv[(size_t)(s * 3 + 1) * 3072 + c], b2 = state_conv[(size_t)(s * 3 + 2) * 3072 + c];
            const float uu = bf2f(QKV[row * 3072 + c]);
            float* cs = p.out + O_CONVS + (size_t)s * 9216 + c; cs[0] = b1; cs[3072] = b2; cs[6144] = uu;
            const float o = silu(conv_w[c] * b0 + conv_w[3072 + c] * b1 + conv_w[6144 + c] * b2 + conv_w[9216 + c] * uu);
            (sel == 0 ? qs : (sel == 1 ? ksm : vs))[d] = o;
        }
        BLOCK_BAR();
        if (wave < 3) {
            const float q0 = qs[lane], q1 = qs[lane + 64], k0 = ksm[lane], k1 = ksm[lane + 64];
            float v = wave == 0 ? q0 * q0 + q1 * q1 : (wave == 1 ? k0 * k0 + k1 * k1 : q0 * k0 + q1 * k1);
            v = wave_sum(v); if (lane == 0) sc[wave] = v;
        }
        BLOCK_BAR();
        const float rq = rsqrtf(sc[0] + EPS) * 0.08838834764831845f, rk = rsqrtf(sc[1] + EPS), qk = sc[2] * rq * rk;
        const float xx = a + dtb; const float sp = xx > 20.f ? xx : log1pf(expf(xx));
        const float eg = expf(-expf(alg) * sp), beta = 1.f / (1.f + expf(-bl));
        f32x4 pk = {0.f, 0.f, 0.f, 0.f}, pq = pk;
#pragma unroll
        for (int i = 0; i < 8; ++i) { const int d = dgrp * 8 + i; pk += s0[i] * (ksm[d] * rk); pq += s0[i] * (qs[d] * rq); }
        *(LAS f32x4*)(part + dgrp * 128 + 4 * e4) = pk; *(LAS f32x4*)(part + (16 + dgrp) * 128 + 4 * e4) = pq;
        BLOCK_BAR();
        if (tid < 128) {
            float kS = 0.f, qS = 0.f;
#pragma unroll
            for (int g = 0; g < 16; ++g) { kS += part[g * 128 + tid]; qS += part[(16 + g) * 128 + tid]; }
            const float vn = beta * (vs[tid] - eg * kS);
            vnew[tid] = vn; osm[tid] = eg * qS + qk * vn;
        }
        BLOCK_BAR();
        {
            const f32x4 vn4 = *(const LAS f32x4*)(vnew + 4 * e4);
            float* So = p.out + O_SSMS + (size_t)(s * 8 + h) * 16384;
#pragma unroll
            for (int i = 0; i < 8; ++i) { const int d = dgrp * 8 + i; __builtin_nontemporal_store(s0[i] * eg + vn4 * (ksm[d] * rk), (f32x4*)(So + d * 128 + 4 * e4)); }
        }
        if (wave == 0) {
            const float o0 = osm[lane], o1 = osm[lane + 64];
            const float rr = rsqrtf(wave_sum(o0 * o0 + o1 * o1) * (1.f / 128.f) + EPS);
            const float g0 = bf2f(GATE[row * 1024 + h * 128 + lane]), g1 = bf2f(GATE[row * 1024 + h * 128 + lane + 64]);
            const float r0 = o0 * rr * o_norm[lane] * silu(g0), r1 = o1 * rr * o_norm[lane + 64] * silu(g1);
            A2[row * 1024 + h * 128 + lane] = (bf16_t)(cvt_pk(r0, 0.f) & 0xffffu); A2[row * 1024 + h * 128 + lane + 64] = (bf16_t)(cvt_pk(r1, 0.f) & 0xffffu);
        }
        BLOCK_BAR();
    }
}

DEV void window_shift(const Params& p, int tid, int nb, int sb) {
    constexpr int PER = 128 * 127 * 64;
    for (int base = sb * 512 + tid; base < 2 * PER; base += 16 * nb * 512) {
        f32x4 v[16];
#pragma unroll
        for (int q8 = 0; q8 < 16; ++q8) { const int idx = base + q8 * nb * 512;
            if (idx < 2 * PER) { const int which = idx / PER, rem = idx % PER, s = rem / (127 * 64), q = rem % (127 * 64);
                v[q8] = __builtin_nontemporal_load((const f32x4*)((which ? p.in[5] : p.in[4]) + (size_t)s * 32768 + 256 + q * 4)); } }
#pragma unroll
        for (int q8 = 0; q8 < 16; ++q8) { const int idx = base + q8 * nb * 512;
            if (idx < 2 * PER) { const int which = idx / PER, rem = idx % PER, s = rem / (127 * 64), q = rem % (127 * 64);
                __builtin_nontemporal_store(v[q8], (f32x4*)(p.out + (which ? O_VWS : O_KWS) + (size_t)s * 32768 + q * 4)); } }
    }
}

DEV void phase4_skinny(const Params& p, unsigned char* lds, int lane, int wave, int G, int bid) {
    const int fr = lane & 15, fq = lane >> 4;
    const bf16_t* A2 = (const bf16_t*)(p.ws + WS_A2); const bf16_t* W2T = (const bf16_t*)(p.ws + WS_W2T);
    bf16_t* H1B = (bf16_t*)(p.ws + WS_H1B); float* SS2 = (float*)(p.ws + WS_SS2);
    for (int u = bid; u < 64; u += G) {
        const int s = 16 * wave + fr; const size_t row = NP + s; const int col = 16 * u + 4 * fq;
        const f32x4 xres = *(const f32x4*)(p.in[1] + (size_t)s * 1024 + col);
        const f32x4 acc = skinny_mma(A2 + (size_t)NP * 1024, W2T, 16 * u, wave, fr, fq, lds);
        const f32x4 hv = xres + acc;
        *(u32x2*)(H1B + row * 1024 + col) = pack4(hv);
        float sq = (hv[0] * hv[0] + hv[1] * hv[1]) + (hv[2] * hv[2] + hv[3] * hv[3]);
        sq += __shfl_xor(sq, 16); sq += __shfl_xor(sq, 32);
        if (fq == 0) __hip_atomic_fetch_add(SS2 + row, sq, __ATOMIC_RELAXED, __HIP_MEMORY_SCOPE_AGENT);
    }
}
DEV void phase5_skinny(const Params& p, unsigned char* lds, int lane, int wave, int G, int bid) {
    const int fr = lane & 15, fq = lane >> 4;
    const bf16_t* H1B = (const bf16_t*)(p.ws + WS_H1B); const bf16_t* W3T = (const bf16_t*)(p.ws + WS_W3T); const float* SS2 = (const float*)(p.ws + WS_SS2);
    bf16_t* KVQG = (bf16_t*)(p.ws + WS_KVQG);
    for (int u = (bid >= 128 ? bid - 128 : bid + G - 128); u < 160; u += G) {
        const size_t row = NP + 16 * wave + fr; const float ssv = SS2[row];
        const f32x4 acc = skinny_mma(H1B + (size_t)NP * 1024, W3T, 16 * u, wave, fr, fq, lds);
        const float sc = rsqrtf(ssv * (1.f / 1024.f) + EPS);
        *(u32x2*)(KVQG + row * 2560 + 16 * u + 4 * fq) = pack4(acc * sc);
    }
    if (bid >= 128) window_shift(p, threadIdx.x, G - 128, bid - 128);
}
DEV void phase7_skinny(const Params& p, unsigned char* lds, int lane, int wave, int G, int bid) {
    const int fr = lane & 15, fq = lane >> 4;
    const bf16_t* A3 = (const bf16_t*)(p.ws + WS_A3); const bf16_t* W4T = (const bf16_t*)(p.ws + WS_W4T); const bf16_t* H1B = (const bf16_t*)(p.ws + WS_H1B);
    for (int u = bid; u < 64; u += G) {
        const int s = 16 * wave + fr; const size_t row = NP + s;
        const u32x2 hb = *(const u32x2*)(H1B + row * 1024 + 16 * u + 4 * fq);
        const f32x4 accv = skinny_mma(A3 + (size_t)NP * 1024, W4T, 16 * u, wave, fr, fq, lds);
        { const int col = 16 * u + 4 * fq; f32x4 hv; hv[0] = __uint_as_float(hb.x << 16); hv[1] = __uint_as_float(hb.x & 0xffff0000u); hv[2] = __uint_as_float(hb.y << 16); hv[3] = __uint_as_float(hb.y & 0xffff0000u);
            *(f32x4*)(p.out + O_YS + (size_t)s * 1024 + col) = hv + accv; }
    }
}

DEV void phase6(const Params& p, unsigned char* lds, int tid, int lane, int wave, int G, int bid) {
    const int fr = lane & 15, fq = lane >> 4;
    LAS bf16_t* Ks = (LAS bf16_t*)lds;
    LAS bf16_t* Vs = (LAS bf16_t*)((LAS unsigned char*)lds + 36864);
    LAS float* wsc = (LAS float*)((LAS unsigned char*)lds + 73728) + wave * 832;
    LAS bf16_t* Ost = (LAS bf16_t*)((LAS unsigned char*)lds + 73728) + wave * 4608;
    const bf16_t* KVQG = (const bf16_t*)(p.ws + WS_KVQG); bf16_t* A3 = (bf16_t*)(p.ws + WS_A3);
    const float* k_norm = p.in[15]; const float* q_norm = p.in[18]; const float* sinks = p.in[19];
    float qnw[16];
#pragma unroll
    for (int j = 0; j < 16; ++j) qnw[j] = q_norm[32 * (j >> 3) + 8 * fq + (j & 7)] * 0.125f;
    for (int u = bid; u < 512; u += G) {
        const int kvh = u & 3, blk = (u >> 2) & 31, b = u >> 7;
        const int qh = kvh * 4 + (wave >> 1), i0 = 64 * (wave & 1);
        const float slope = exp2f(-0.5f * (float)(qh + 1)), sink = sinks[qh];
        const bf16_t* qgbase = KVQG + ((size_t)b * 4096 + blk * 128 + i0 + fr) * 2560 + qh * 64;
        bf16x8 qc[2]; u32x2 gc[4];
#pragma unroll
        for (int ks = 0; ks < 2; ++ks) qc[ks] = *(const bf16x8*)(qgbase + 512 + 32 * ks + 8 * fq);
#pragma unroll
        for (int dt = 0; dt < 4; ++dt) gc[dt] = *(const u32x2*)(qgbase + 1536 + 16 * dt + 4 * fq);
        {
            const int r = tid >> 1, hf = tid & 1; const int tok = (blk - 1) * 128 + r;
            float kv[32]; float ss = 0.f; bf16x8 vv[4];
            if (tok >= 0) {
                const bf16_t* src = KVQG + ((size_t)b * 4096 + tok) * 2560 + kvh * 64 + 32 * hf;
#pragma unroll
                for (int q = 0; q < 4; ++q) { const bf16x8 x = *(const bf16x8*)(src + 8 * q); vv[q] = *(const bf16x8*)(src + 256 + 8 * q);
#pragma unroll
                    for (int j = 0; j < 8; ++j) { const float f = bf2f(x[j]); kv[8 * q + j] = f; ss += f * f; } }
            } else {
#pragma unroll
                for (int j = 0; j < 32; ++j) kv[j] = 0.f;
#pragma unroll
                for (int q = 0; q < 4; ++q) vv[q] = (bf16x8){0, 0, 0, 0, 0, 0, 0, 0};
            }
            ss += __shfl_xor(ss, 1);
            const float rr = rsqrtf(ss * (1.f / 64.f) + EPS);
#pragma unroll
            for (int j = 0; j < 32; ++j) kv[j] *= rr * k_norm[32 * hf + j];
#pragma unroll
            for (int q = 0; q < 4; ++q) { *(LAS bf16x8*)(Ks + r * 72 + 32 * hf + 8 * q) = pack8(kv + 8 * q); *(LAS bf16x8*)(Vs + r * 72 + 32 * hf + 8 * q) = vv[q]; }
            if (blk == 31 && r >= 128) {
                float* kd = p.out + O_KWP + ((size_t)(b * 128 + (r - 128)) * 4 + kvh) * 64 + 32 * hf; float* vd = p.out + O_VWP + ((size_t)(b * 128 + (r - 128)) * 4 + kvh) * 64 + 32 * hf;
#pragma unroll
                for (int q = 0; q < 8; ++q) *(f32x4*)(kd + 4 * q) = (f32x4){kv[4 * q], kv[4 * q + 1], kv[4 * q + 2], kv[4 * q + 3]};
#pragma unroll
                for (int q = 0; q < 4; ++q) { *(f32x4*)(vd + 8 * q) = (f32x4){bf2f(vv[q][0]), bf2f(vv[q][1]), bf2f(vv[q][2]), bf2f(vv[q][3])}; *(f32x4*)(vd + 8 * q + 4) = (f32x4){bf2f(vv[q][4]), bf2f(vv[q][5]), bf2f(vv[q][6]), bf2f(vv[q][7])}; }
            }
        }
        BLOCK_BAR();
#pragma unroll 1
        for (int qt = 0; qt < 4; ++qt) {
            const int iq = i0 + 16 * qt + fr;
            bf16x8 qn[2]; u32x2 gn[4];
            { const bf16_t* nb_ = qgbase + (size_t)(16 * (qt < 3 ? qt + 1 : 3)) * 2560;
#pragma unroll
                for (int ks = 0; ks < 2; ++ks) qn[ks] = *(const bf16x8*)(nb_ + 512 + 32 * ks + 8 * fq);
#pragma unroll
                for (int dt = 0; dt < 4; ++dt) gn[dt] = *(const u32x2*)(nb_ + 1536 + 16 * dt + 4 * fq); }
            bf16x8 Qf[2];
            {
                float qv[16]; float ss = 0.f;
#pragma unroll
                for (int ks = 0; ks < 2; ++ks) { const bf16x8 x = qc[ks];
#pragma unroll
                    for (int j = 0; j < 8; ++j) { const float f = bf2f(x[j]); qv[8 * ks + j] = f; ss += f * f; } }
                ss += __shfl_xor(ss, 16); ss += __shfl_xor(ss, 32);
                const float rr = rsqrtf(ss * (1.f / 64.f) + EPS);
#pragma unroll
                for (int ks = 0; ks < 2; ++ks) {
#pragma unroll
                    for (int j = 0; j < 8; ++j) qv[8 * ks + j] *= rr * qnw[8 * ks + j];
                    Qf[ks] = pack8(qv + 8 * ks); }
            }
            const int kts = ((i0 >> 4) + qt) & ~1;
            f32x4 st[10]; float mx = -INFINITY;
#pragma unroll
            for (int tt = 0; tt < 10; ++tt) {
                const int kt = kts + tt; f32x4 c = {0.f, 0.f, 0.f, 0.f};
#pragma unroll
                for (int ks = 0; ks < 2; ++ks) c = mfma16(*(const LAS bf16x8*)(Ks + (16 * kt + fr) * 72 + 32 * ks + 8 * fq), Qf[ks], c);
#pragma unroll
                for (int r = 0; r < 4; ++r) { const int j = 16 * kt + 4 * fq + r, dist = iq - j + 128;
                    const bool ok = dist >= 0 && dist <= 128 && (blk > 0 || j >= 128);
                    c[r] = ok ? c[r] - slope * (float)dist : -INFINITY; mx = fmaxf(mx, c[r]); }
                st[tt] = c;
            }
            mx = fmaxf(mx, __shfl_xor(mx, 16)); mx = fmaxf(mx, __shfl_xor(mx, 32)); mx = fmaxf(mx, sink);
            float sum = 0.f;
#pragma unroll
            for (int tt = 0; tt < 10; ++tt)
#pragma unroll
                for (int r = 0; r < 4; ++r) { const float e = __expf(st[tt][r] - mx); st[tt][r] = e; sum += e; }
            sum += __shfl_xor(sum, 16); sum += __shfl_xor(sum, 32);
            const float inv = 1.f / (sum + __expf(sink - mx));
            bf16x8 Pf[5];
#pragma unroll
            for (int k2 = 0; k2 < 5; ++k2) Pf[k2] = pack44(st[2 * k2], st[2 * k2 + 1]);
#pragma unroll
            for (int dt = 0; dt < 4; ++dt) {
                f32x4 o = {0.f, 0.f, 0.f, 0.f};
#pragma unroll
                for (int k2 = 0; k2 < 5; ++k2) { const int kb = 16 * (kts + 2 * k2);
                    const bf16x8 a = cat4(ldstr(Vs, 72, kb + 4 * fq, 16 * dt, fr), ldstr(Vs, 72, kb + 16 + 4 * fq, 16 * dt, fr));
                    o = mfma16(a, Pf[k2], o); }
                const u32x2 gw = gc[dt];
                f32x4 g; g[0] = __uint_as_float(gw.x << 16); g[1] = __uint_as_float(gw.x & 0xffff0000u); g[2] = __uint_as_float(gw.y << 16); g[3] = __uint_as_float(gw.y & 0xffff0000u);
#pragma unroll
                for (int r = 0; r < 4; ++r) o[r] = o[r] * inv * silu(g[r]);
                *(LAS u32x2*)(Ost + (16 * qt + fr) * 72 + 16 * dt + 4 * fq) = pack4(o);
            }
#pragma unroll
            for (int ks = 0; ks < 2; ++ks) qc[ks] = qn[ks];
#pragma unroll
            for (int dt = 0; dt < 4; ++dt) gc[dt] = gn[dt];
        }
#pragma unroll
        for (int i = 0; i < 8; ++i) { const int r = 8 * i + (lane >> 3), ch = lane & 7;
            *(bf16x8*)(A3 + ((size_t)b * 4096 + blk * 128 + i0 + r) * 1024 + qh * 64 + 8 * ch) = *(const LAS bf16x8*)(Ost + r * 72 + 8 * ch); }
        BLOCK_BAR();
    }
    for (int su = wave * G + bid; su < 512; su += 8 * G) {
        const int s = su >> 2, kvh = su & 3; const size_t row = NP + s;
        LAS float* qsm = wsc; LAS float* psm = wsc + 256;
        float kn = bf2f(KVQG[row * 2560 + kvh * 64 + lane]); const float vn = bf2f(KVQG[row * 2560 + 256 + kvh * 64 + lane]);
        kn *= rsqrtf(wave_sum(kn * kn) * (1.f / 64.f) + EPS) * k_norm[lane];
        p.out[O_KWS + ((size_t)(s * 128 + 127) * 4 + kvh) * 64 + lane] = kn; p.out[O_VWS + ((size_t)(s * 128 + 127) * 4 + kvh) * 64 + lane] = vn;
        float qg[4], snew[4];
#pragma unroll
        for (int g = 0; g < 4; ++g) { float q = bf2f(KVQG[row * 2560 + 512 + (kvh * 4 + g) * 64 + lane]);
            q *= rsqrtf(wave_sum(q * q) * (1.f / 64.f) + EPS) * q_norm[lane] * 0.125f; qg[g] = q; qsm[g * 64 + lane] = q; snew[g] = wave_sum(q * kn); }
        asm volatile("s_waitcnt lgkmcnt(0)" ::: "memory");
        const float* kc0 = p.in[4] + ((size_t)(s * 128 + lane) * 4 + kvh) * 64; const float* kc1 = kc0 + 64 * 256;
        float s0[4] = {0.f, 0.f, 0.f, 0.f}, s1[4] = {0.f, 0.f, 0.f, 0.f};
#pragma unroll 8
        for (int d4 = 0; d4 < 16; ++d4) { const f32x4 x0 = *(const f32x4*)(kc0 + 4 * d4), x1 = *(const f32x4*)(kc1 + 4 * d4);
#pragma unroll
            for (int g = 0; g < 4; ++g) { const f32x4 q4 = *(const LAS f32x4*)(qsm + g * 64 + 4 * d4);
                s0[g] += (q4[0] * x0[0] + q4[1] * x0[1]) + (q4[2] * x0[2] + q4[3] * x0[3]); s1[g] += (q4[0] * x1[0] + q4[1] * x1[1]) + (q4[2] * x1[2] + q4[3] * x1[3]); } }
        float inv[4];
#pragma unroll
        for (int g = 0; g < 4; ++g) {
            const int qh = kvh * 4 + g; const float slope = exp2f(-0.5f * (float)(qh + 1)), sink = sinks[qh];
            const float a0 = s0[g] - slope * (float)(128 - lane), a1 = s1[g] - slope * (float)(64 - lane), a2 = snew[g];
            const float mx = fmaxf(fmaxf(wave_max(fmaxf(a0, a1)), a2), sink);
            const float e0 = __expf(a0 - mx), e1 = __expf(a1 - mx), e2 = __expf(a2 - mx);
            inv[g] = 1.f / (wave_sum(e0 + e1) + e2 + __expf(sink - mx));
            psm[lane * 4 + g] = e0; psm[(lane + 64) * 4 + g] = e1; if (lane == 0) psm[128 * 4 + g] = e2;
        }
        asm volatile("s_waitcnt lgkmcnt(0)" ::: "memory");
        f32x4 o4[4];
#pragma unroll
        for (int g = 0; g < 4; ++g) o4[g] = (f32x4){0.f, 0.f, 0.f, 0.f};
        const int g4 = lane >> 4, d4 = lane & 15;
        const float* vc = p.in[5] + ((size_t)(s * 128 + g4) * 4 + kvh) * 64 + 4 * d4;
#pragma unroll 16
        for (int j = 0; j < 32; ++j) { const f32x4 v = *(const f32x4*)(vc + (size_t)j * 1024); const f32x4 p4 = *(const LAS f32x4*)(psm + 4 * (4 * j + g4));
#pragma unroll
            for (int g = 0; g < 4; ++g) o4[g] += v * p4[g]; }
#pragma unroll
        for (int g = 0; g < 4; ++g)
#pragma unroll
            for (int e = 0; e < 4; ++e) { float t = o4[g][e]; t += __shfl_xor(t, 16); t += __shfl_xor(t, 32); o4[g][e] = t; }
        {
            const f32x4 p4 = *(const LAS f32x4*)(psm + 4 * 128);
            f32x4 vne4;
#pragma unroll
            for (int e = 0; e < 4; ++e) vne4[e] = __shfl(vn, 4 * d4 + e);
            if (g4 == 0) {
#pragma unroll
                for (int g = 0; g < 4; ++g) { const int qh = kvh * 4 + g;
                    const u32x2 gw = *(const u32x2*)(KVQG + row * 2560 + 1536 + qh * 64 + 4 * d4);
                    f32x4 gg; gg[0] = __uint_as_float(gw.x << 16); gg[1] = __uint_as_float(gw.x & 0xffff0000u); gg[2] = __uint_as_float(gw.y << 16); gg[3] = __uint_as_float(gw.y & 0xffff0000u);
                    f32x4 r;
#pragma unroll
                    for (int e = 0; e < 4; ++e) r[e] = (o4[g][e] + p4[g] * vne4[e]) * inv[g] * silu(gg[e]);
                    *(u32x2*)(A3 + row * 1024 + qh * 64 + 4 * d4) = pack4(r); }
            }
        }
        asm volatile("s_waitcnt lgkmcnt(0)" ::: "memory");
    }
}

#define XB_TMO      128
#define XB_XCNT(j)  (256  + 64 * (j))
#define XB_XSUB(j)  (1280 + 64 * (j))
#define XB_XGEN(j)  (2304 + 64 * (j))
#define XB_TOP      3328
#define XB_TOPGEN   3392
#define XCD_BAR_WORDS 3456
#define XB_SPIN_CAP (1u << 18)

__device__ __forceinline__ unsigned xb_ld(unsigned* p)              { return __hip_atomic_load(p, __ATOMIC_RELAXED, __HIP_MEMORY_SCOPE_AGENT); }
__device__ __forceinline__ unsigned xb_add(unsigned* p, unsigned v) { return __hip_atomic_fetch_add(p, v, __ATOMIC_RELAXED, __HIP_MEMORY_SCOPE_AGENT); }
__device__ __forceinline__ unsigned xb_xcc_id() { return (unsigned)__builtin_amdgcn_s_getreg((3 << 11) | 20) & 0xFu; }
#define XB_SPIN(cond, bar) do { unsigned _sp = 0; while (cond) { __builtin_amdgcn_s_sleep(1); \
    if ((++_sp & 255u) == 0u) { if (xb_ld(&(bar)[XB_TMO])) break; if (_sp > XB_SPIN_CAP) { atomicAdd(&(bar)[XB_TMO], 1u); break; } } } } while (0)

struct XcdBarrier {
    unsigned* bar; unsigned x;
    volatile LAS unsigned* st;
};

__device__ __forceinline__ XcdBarrier xcd_barrier_post(unsigned* bar, volatile LAS unsigned* st) {
    XcdBarrier b; b.bar = bar; b.x = xb_xcc_id(); b.st = st;
    if (threadIdx.x == 0) (void)xb_add(&bar[XB_XCNT(b.x)], 1u);
    return b;
}
__device__ __forceinline__ void xcd_barrier_complete(unsigned* bar, unsigned x, unsigned& nloc, unsigned& nx) {
    const unsigned G = gridDim.x * gridDim.y * gridDim.z;
    unsigned sum, cnt, mine, sp = 0u;
    for (;;) {
        sum = 0u; cnt = 0u; mine = 0u;
#pragma unroll
        for (unsigned j = 0; j < 16; ++j) { const unsigned c = xb_ld(&bar[XB_XCNT(j)]); sum += c; cnt += (c > 0u) ? 1u : 0u; mine = (j == x) ? c : mine; }
        if (sum == G) break;
        __builtin_amdgcn_s_sleep(1);
        if ((++sp & 255u) == 0u) { if (xb_ld(&bar[XB_TMO])) break; if (sp > XB_SPIN_CAP) { atomicAdd(&bar[XB_TMO], 1u); break; } }
    }
    nloc = mine > 0u ? mine : 1u; nx = cnt > 0u ? cnt : 1u;
}

__device__ __forceinline__ void xcd_barrier(const XcdBarrier& b) {
    asm volatile("s_waitcnt vmcnt(0)" ::: "memory");
    __syncthreads();
    if (threadIdx.x == 0) {
        unsigned* bar = b.bar;
        __builtin_amdgcn_s_waitcnt(0);
        unsigned nloc = b.st[0], nx = b.st[1];
        if (nloc == 0u) { xcd_barrier_complete(bar, b.x, nloc, nx); b.st[0] = nloc; b.st[1] = nx; }
        const unsigned old = xb_add(&bar[XB_XSUB(b.x)], 1u);
        const unsigned gen = old / nloc;
        if (old + 1u == (gen + 1u) * nloc) {
            __builtin_amdgcn_fence(__ATOMIC_RELEASE, "agent");
            asm volatile("s_waitcnt vmcnt(0)" ::: "memory");
            const unsigned og = xb_add(&bar[XB_TOP], 1u);
            const unsigned tg = og / nx;
            if (og + 1u == (tg + 1u) * nx) xb_add(&bar[XB_TOPGEN], 1u);
            else XB_SPIN(xb_ld(&bar[XB_TOPGEN]) == tg, bar);
            __builtin_amdgcn_fence(__ATOMIC_ACQUIRE, "agent");
            xb_add(&bar[XB_XGEN(b.x)], 1u);
            asm volatile("s_waitcnt vmcnt(0)" ::: "memory");
        } else {
            XB_SPIN(xb_ld(&bar[XB_XGEN(b.x)]) == gen, bar);
            __builtin_amdgcn_fence(__ATOMIC_ACQUIRE, "agent");
            asm volatile("s_waitcnt vmcnt(0)" ::: "memory");
        }
    }
    __syncthreads();
}

__global__ void __launch_bounds__(512, 2) yoco_fwd(Params p) {
    extern __shared__ __attribute__((aligned(16))) unsigned char lds[];
    cg::grid_group grid = cg::this_grid();
    const int tid = threadIdx.x, lane = tid & 63, wave = __builtin_amdgcn_readfirstlane(tid >> 6);
    const int G = gridDim.x, bid = blockIdx.x;
    const int lo = p.ph_lo, hi = p.ph_hi & 255, dbl = (p.ph_hi >> 8) - 1;
    volatile LAS unsigned* bst = (volatile LAS unsigned*)((LAS unsigned char*)lds + LDS_BYTES - 64);
    if (tid < 2) bst[tid] = 0u;
    __syncthreads();
    XcdBarrier xbar = xcd_barrier_post((unsigned*)(p.ws + WS_CTL), bst);
    if (lo < 0) grid.sync();
#define IN(k) (lo <= (k) && (k) < hi)
#define SEAM(k) do { if (IN(k) && IN((k) + 1)) xcd_barrier(xbar); } while (0)
#define RUN(k) (IN(k) ? (1 + (dbl == (k))) : 0)
    PG8_LAS unsigned char* ring = (PG8_LAS unsigned char*)lds;
    if (IN(0)) { phase0(p, lds, lane, wave, G, bid); }
    SEAM(0);
    if (IN(1)) {
        pg8::Gemm g{(const bf16_t*)(p.ws + WS_XB), (const bf16_t*)(p.ws + WS_W1T), NP, 4096, 1024}; pg8::StaticOrder S; S.init(NP, 4096, G, bid);
        Epi<1> E{(bf16_t*)(p.ws + WS_QKV), (bf16_t*)(p.ws + WS_GATE), nullptr, nullptr, nullptr, (const float*)(p.ws + WS_RS1), nullptr};
        pg8::gemm_phase<Epi<1>, pg8::StaticOrder, true, true>(ring, g, S, E);
        phase1_skinny(p, lds, lane, wave, G, bid);
    }
    SEAM(1);
    if (IN(2)) { phase2(p, lds, tid, lane, wave, G, bid); }
    SEAM(2);
    if (IN(3)) { phase3_scan(p, lds, lane, wave, bid); }
    SEAM(3);
    if (IN(4)) { phase4_onorm(p, tid, G, bid); phase3_sample(p, lds, tid, lane, wave, G, bid); }
    SEAM(4);
    if (IN(5)) {
        pg8::Gemm g{(const bf16_t*)(p.ws + WS_A2), (const bf16_t*)(p.ws + WS_W2T), NP, 1024, 1024}; pg8::StaticOrder S; S.init(NP, 1024, G, bid);
        Epi<4> E{(bf16_t*)(p.ws + WS_H1B), nullptr, nullptr, p.in[0], (float*)(p.ws + WS_SS2), nullptr, nullptr};
        pg8::gemm_phase<Epi<4>, pg8::StaticOrder, true, true>(ring, g, S, E);
        phase4_skinny(p, lds, lane, wave, G, bid);
    }
    SEAM(5);
    if (IN(6)) {
        pg8::Gemm g{(const bf16_t*)(p.ws + WS_H1B), (const bf16_t*)(p.ws + WS_W3T), NP, 2560, 1024}; pg8::StaticOrder S; S.init(NP, 2560, G, bid);
        Epi<5> E{(bf16_t*)(p.ws + WS_KVQG), nullptr, nullptr, nullptr, (float*)(p.ws + WS_SS2), nullptr, nullptr};
        pg8::gemm_phase<Epi<5>, pg8::StaticOrder, true, true>(ring, g, S, E);
        phase5_skinny(p, lds, lane, wave, G, bid);
    }
    SEAM(6);
    if (IN(7)) { phase6(p, lds, tid, lane, wave, G, bid); }
    SEAM(7);
    if (IN(8)) {
        pg8::Gemm g{(const bf16_t*)(p.ws + WS_A3), (const bf16_t*)(p.ws + WS_W4T), NP, 1024, 1024}; pg8::StaticOrder S; S.init(NP, 1024, G, bid);
        Epi<7> E{nullptr, nullptr, p.out + O_YP, nullptr, nullptr, nullptr, (const bf16_t*)(p.ws + WS_H1B)};
        pg8::gemm_phase<Epi<7>, pg8::StaticOrder, true, true>(ring, g, S, E);
        phase7_skinny(p, lds, lane, wave, G, bid);
    }
#undef IN
#undef SEAM
}

extern "C" void kernel_launch(void* const* d_in, const int* in_sizes, int n_in, void* d_out, int out_size, void* d_ws, size_t ws_size, hipStream_t stream) {
    static int grid = 0;
    if (grid == 0) {
        if (n_in != 21 || ws_size < WS_END) { fprintf(stderr, "kernel_launch: unexpected n_in %d / ws %zu\n", n_in, ws_size); grid = -1; return; }
        int dev = 0, cus = 0, per_cu = 0;
        if (hipGetDevice(&dev) != hipSuccess || hipDeviceGetAttribute(&cus, hipDeviceAttributeMultiprocessorCount, dev) != hipSuccess) { grid = -1; return; }
        if (hipFuncSetAttribute((const void*)yoco_fwd, hipFuncAttributeMaxDynamicSharedMemorySize, LDS_BYTES) != hipSuccess) { fprintf(stderr, "kernel_launch: hipFuncSetAttribute failed\n"); grid = -1; return; }
        if (hipOccupancyMaxActiveBlocksPerMultiprocessor(&per_cu, (const void*)yoco_fwd, 512, LDS_BYTES) != hipSuccess || per_cu < 1) { fprintf(stderr, "kernel_launch: occupancy query says %d\n", per_cu); }
        (void)hipGetLastError();
        grid = cus;
        if (grid != 256) fprintf(stderr, "kernel_launch: note: %d CUs\n", grid);
    }
    if (grid < 0) return;
    (void)hipMemsetAsync((char*)d_ws + WS_CTL, 0, 16384, stream);
    Params p{};
    for (int i = 0; i < 21; ++i) p.in[i] = (const float*)d_in[i];
    p.out = (float*)d_out; p.ws = (unsigned char*)d_ws;
#if MK_N_LAUNCHES == 1
    p.ph_lo = 0; p.ph_hi = 9 | ((MK_DOUBLE + 1) << 8);
    void* args[] = {&p};
    hipError_t e = hipLaunchCooperativeKernel((const void*)yoco_fwd, dim3(grid), dim3(512), args, LDS_BYTES, stream);
    if (e != hipSuccess) fprintf(stderr, "cooperative launch failed: %s (grid %d)\n", hipGetErrorString(e), grid);
#else
    for (int k = 0; k < MK_STOP; ++k) { p.ph_lo = k; p.ph_hi = k + 1; hipLaunchKernelGGL(yoco_fwd, dim3(grid), dim3(512), LDS_BYTES, stream, p); }
    if (MK_STOP < 9) (void)hipMemsetAsync(d_out, 0, (size_t)16777216 * 4, stream);
#endif
}
```
